# Optimizing an MI355X kernel written in HIP

```python
import math
import jax, jax.numpy as jnp
from jax import lax
import numpy as np

D_MODEL = 4096
BATCH = 4
SEQ = 4096
DEPTH = 4

N_MIXERS = 3
N_HEADS = 32
HEAD_DIM = D_MODEL // N_HEADS
LRU_WIDTH = (4 * D_MODEL // 3) // 256 * 256
LRU_BLOCKS = 16
LRU_BLOCK_WIDTH = LRU_WIDTH // LRU_BLOCKS
LRU_C = 8.0
CONV_WIDTH = 4
SB_QBLOCK = 128
MOBA_BLOCK = 256
MOBA_TOPK = 3
MOBA_QCHUNK = 16
D_FF = 4 * D_MODEL
REL_BUCKETS = 32
REL_MAX_DIST = 128
NORM_EPS = 1e-6
N_LRU_LAYERS = (DEPTH + 2) // 3
N_SB_LAYERS = (DEPTH + 1) // 3
N_MOBA_LAYERS = DEPTH // 3

kernel_name = "hybrid_rglru_stickbreak_moba_trunk"


def rmsnorm(x, g):
    x32 = x.astype(jnp.float32)
    y = x32 * lax.rsqrt(jnp.mean(x32 * x32, axis=-1, keepdims=True) + NORM_EPS)
    return (y * g.astype(jnp.float32)).astype(x.dtype)


def t5_bucket(dist):
    n = jnp.maximum(dist, 0)
    max_exact = REL_BUCKETS // 2
    n_f = jnp.maximum(n, 1).astype(jnp.float32)
    large = max_exact + (jnp.log(n_f / max_exact) / math.log(REL_MAX_DIST / max_exact)
                         * (REL_BUCKETS - max_exact)).astype(jnp.int32)
    large = jnp.minimum(large, REL_BUCKETS - 1)
    return jnp.where(n < max_exact, n, large)


def causal_depthwise_conv(x, w, b):
    S = x.shape[1]
    xp = jnp.pad(x, ((0, 0), (CONV_WIDTH - 1, 0), (0, 0)))
    y = b
    for k in range(CONV_WIDTH):
        y = y + xp[:, k:k + S] * w[k]
    return y


def rglru_block(h, w_in, b_in, conv_w, conv_b, w_ga, b_ga, w_gx, b_gx, lam, w_out, b_out):
    B, S, _ = h.shape
    u = h @ w_in + b_in
    gate_branch = jax.nn.gelu(u[..., :LRU_WIDTH], approximate=True)
    xb = causal_depthwise_conv(u[..., LRU_WIDTH:], conv_w, conv_b)
    xh = xb.reshape(B, S, LRU_BLOCKS, LRU_BLOCK_WIDTH)
    r = jax.nn.sigmoid((jnp.einsum('bsnc,ncd->bsnd', xh, w_ga).reshape(B, S, LRU_WIDTH) + b_ga).astype(jnp.float32))
    i = jax.nn.sigmoid((jnp.einsum('bsnc,ncd->bsnd', xh, w_gx).reshape(B, S, LRU_WIDTH) + b_gx).astype(jnp.float32))
    log_a = -LRU_C * r * jax.nn.softplus(-lam.astype(jnp.float32))
    a = jnp.exp(log_a)
    inp = jnp.sqrt(-jnp.expm1(2.0 * log_a)) * (i * xb.astype(jnp.float32))

    def combine(c1, c2):
        a1, b1 = c1
        a2, b2 = c2
        return a1 * a2, a2 * b1 + b2

    _, hs = lax.associative_scan(combine, (a, inp), axis=1)
    y = hs.astype(h.dtype) * gate_branch
    return y @ w_out + b_out


def split_heads(h, w_qkv):
    B, S, _ = h.shape
    qkv = (h @ w_qkv).reshape(B, S, 3, N_HEADS, HEAD_DIM)
    q = jnp.moveaxis(qkv[:, :, 0], 1, 2)
    k = jnp.moveaxis(qkv[:, :, 1], 1, 2)
    v = jnp.moveaxis(qkv[:, :, 2], 1, 2)
    return q, k, v


def merge_heads(o, w_o):
    B, H, S, hd = o.shape
    return jnp.moveaxis(o, 1, 2).reshape(B, S, H * hd) @ w_o


def stick_breaking_attention(q, k, v):
    S = q.shape[2]
    scale = HEAD_DIM ** -0.5
    outs = []
    for t0 in range(0, S, SB_QBLOCK):
        t1 = t0 + SB_QBLOCK
        z = jnp.einsum('bhqd,bhkd->bhqk', q[:, :, t0:t1], k[:, :, :t1]).astype(jnp.float32) * scale
        strict = jnp.arange(t1)[None, :] < jnp.arange(t0, t1)[:, None]
        log_beta = jax.nn.log_sigmoid(z)
        log_keep = jnp.where(strict, jax.nn.log_sigmoid(-z), 0.0)
        later = lax.cumsum(log_keep, axis=3, reverse=True) - log_keep
        w = jnp.where(strict, jnp.exp(log_beta + later), 0.0)
        outs.append(jnp.einsum('bhqk,bhkd->bhqd', w.astype(v.dtype), v[:, :, :t1]))
    return jnp.concatenate(outs, axis=2)


def moba_attention(q, k, v, rel_bias):
    B, H, S, hd = q.shape
    scale = HEAD_DIM ** -0.5
    nkb = -(-S // MOBA_BLOCK)
    pad = nkb * MOBA_BLOCK - S
    k_blocks = jnp.pad(k, ((0, 0), (0, 0), (0, pad), (0, 0))).reshape(B, H, nkb, MOBA_BLOCK, hd)
    v_blocks = jnp.pad(v, ((0, 0), (0, 0), (0, pad), (0, 0))).reshape(B, H, nkb, MOBA_BLOCK, hd)
    k_mean = jnp.mean(k_blocks.astype(jnp.float32), axis=3)
    gate = jnp.einsum('bhsd,bhnd->bhsn', q.astype(jnp.float32), k_mean)
    q_blk = jnp.arange(S) // MOBA_BLOCK
    past = jnp.arange(nkb)[None, :] < q_blk[:, None]
    gate = jnp.where(past, gate, -jnp.inf)
    n_sel = max(1, min(MOBA_TOPK, nkb - 1))
    _, sel = lax.top_k(gate, n_sel)
    sel_valid = sel < q_blk[:, None]

    n_chunks = S // MOBA_QCHUNK

    def to_chunks(a):
        a = a.reshape((B, H, n_chunks, MOBA_QCHUNK) + a.shape[3:])
        a = jnp.moveaxis(a, 2, 1)
        return a.reshape((B * n_chunks, H, MOBA_QCHUNK) + a.shape[4:])

    b_idx = jnp.repeat(jnp.arange(B), n_chunks)
    c_idx = jnp.tile(jnp.arange(n_chunks), B)
    bias_by_head = rel_bias.T.astype(jnp.float32)
    offs = jnp.arange(MOBA_BLOCK)
    gather_blocks = jax.vmap(lambda blocks, idx: blocks[idx])
    lookup_bias = jax.vmap(lambda tab, bk: tab[bk])

    def chunk_fn(args):
        q_c, sel_c, valid_c, bi, ci = args
        kb = k_blocks[bi]
        vb = v_blocks[bi]
        t0 = ci * MOBA_QCHUNK
        t = t0 + jnp.arange(MOBA_QCHUNK)
        own = t0 // MOBA_BLOCK
        k_sel = gather_blocks(kb, sel_c)
        v_sel = gather_blocks(vb, sel_c)
        k_own = lax.dynamic_index_in_dim(kb, own, axis=1, keepdims=False)
        v_own = lax.dynamic_index_in_dim(vb, own, axis=1, keepdims=False)
        l_sel = jnp.einsum('hqd,hqnpd->hqnp', q_c, k_sel).astype(jnp.float32) * scale
        l_own = jnp.einsum('hqd,hpd->hqp', q_c, k_own).astype(jnp.float32) * scale
        d_sel = t[None, :, None, None] - (sel_c[..., None] * MOBA_BLOCK + offs)
        d_own = t[:, None] - (own * MOBA_BLOCK + offs)[None, :]
        l_sel = l_sel + lookup_bias(bias_by_head, t5_bucket(d_sel))
        l_own = l_own + bias_by_head[:, t5_bucket(d_own)]
        l_sel = jnp.where(valid_c[..., None], l_sel, -jnp.inf)
        l_own = jnp.where((d_own >= 0)[None], l_own, -jnp.inf)
        logits = jnp.concatenate([l_sel.reshape(H, MOBA_QCHUNK, n_sel * MOBA_BLOCK), l_own], axis=-1)
        p = jax.nn.softmax(logits, axis=-1)
        p_sel = p[..., :n_sel * MOBA_BLOCK].reshape(H, MOBA_QCHUNK, n_sel, MOBA_BLOCK).astype(v.dtype)
        p_own = p[..., n_sel * MOBA_BLOCK:].astype(v.dtype)
        return (jnp.einsum('hqnp,hqnpd->hqd', p_sel, v_sel)
                + jnp.einsum('hqp,hpd->hqd', p_own, v_own))

    out = lax.map(chunk_fn, (to_chunks(q), to_chunks(sel), to_chunks(sel_valid), b_idx, c_idx))
    out = jnp.moveaxis(out.reshape(B, n_chunks, H, MOBA_QCHUNK, hd), 1, 2)
    return out.reshape(B, H, S, hd)


def squared_relu_mlp(h, w_up, w_down):
    u = jax.nn.relu(h @ w_up)
    return (u * u) @ w_down


def setup_inputs(seed: int = 0) -> dict:
    key = jax.random.key(seed)
    ks = jax.random.split(key, 26)
    f32 = jnp.float32

    def nrm(k, shape, fan_in):
        return jax.random.normal(k, shape, f32) * (fan_in ** -0.5)

    def small(k, shape, s=0.01):
        return jax.random.normal(k, shape, f32) * s

    def gain(k):
        return 1.0 + 0.05 * jax.random.normal(k, (DEPTH, D_MODEL), f32)

    u = jax.random.uniform(ks[14], (N_LRU_LAYERS, LRU_WIDTH), f32, minval=0.9, maxval=0.999)
    a0 = u ** (1.0 / LRU_C)
    lam = jnp.log(a0) - jnp.log1p(-a0)
    return {
        "x": jax.random.normal(ks[0], (BATCH, SEQ, D_MODEL), f32),
        "norm_mix_pre": gain(ks[1]),
        "norm_mix_post": gain(ks[2]),
        "norm_ffn_pre": gain(ks[3]),
        "norm_ffn_post": gain(ks[4]),
        "lru_w_in": nrm(ks[5], (N_LRU_LAYERS, D_MODEL, 2 * LRU_WIDTH), D_MODEL),
        "lru_b_in": small(ks[6], (N_LRU_LAYERS, 2 * LRU_WIDTH)),
        "lru_conv_w": nrm(ks[7], (N_LRU_LAYERS, CONV_WIDTH, LRU_WIDTH), CONV_WIDTH),
        "lru_conv_b": small(ks[8], (N_LRU_LAYERS, LRU_WIDTH)),
        "lru_w_ga": nrm(ks[9], (N_LRU_LAYERS, LRU_BLOCKS, LRU_BLOCK_WIDTH, LRU_BLOCK_WIDTH), LRU_BLOCK_WIDTH),
        "lru_b_ga": small(ks[10], (N_LRU_LAYERS, LRU_WIDTH)),
        "lru_w_gx": nrm(ks[11], (N_LRU_LAYERS, LRU_BLOCKS, LRU_BLOCK_WIDTH, LRU_BLOCK_WIDTH), LRU_BLOCK_WIDTH),
        "lru_b_gx": small(ks[12], (N_LRU_LAYERS, LRU_WIDTH)),
        "lru_lambda": lam,
        "lru_w_out": nrm(ks[15], (N_LRU_LAYERS, LRU_WIDTH, D_MODEL), LRU_WIDTH),
        "lru_b_out": small(ks[16], (N_LRU_LAYERS, D_MODEL)),
        "sb_w_qkv": nrm(ks[17], (N_SB_LAYERS, D_MODEL, 3 * N_HEADS * HEAD_DIM), D_MODEL),
        "sb_w_o": nrm(ks[18], (N_SB_LAYERS, N_HEADS * HEAD_DIM, D_MODEL), N_HEADS * HEAD_DIM),
        "moba_w_qkv": nrm(ks[19], (N_MOBA_LAYERS, D_MODEL, 3 * N_HEADS * HEAD_DIM), D_MODEL),
        "moba_w_o": nrm(ks[20], (N_MOBA_LAYERS, N_HEADS * HEAD_DIM, D_MODEL), N_HEADS * HEAD_DIM),
        "rel_bias": small(ks[21], (REL_BUCKETS, N_HEADS), 0.5),
        "mlp_w_up": nrm(ks[22], (DEPTH, D_MODEL, D_FF), D_MODEL),
        "mlp_w_down": nrm(ks[23], (DEPTH, D_FF, D_MODEL), D_FF),
    }


def reference(x, norm_mix_pre, norm_mix_post, norm_ffn_pre, norm_ffn_post,
              lru_w_in, lru_b_in, lru_conv_w, lru_conv_b, lru_w_ga, lru_b_ga,
              lru_w_gx, lru_b_gx, lru_lambda, lru_w_out, lru_b_out,
              sb_w_qkv, sb_w_o, moba_w_qkv, moba_w_o, rel_bias,
              mlp_w_up, mlp_w_down):
    for layer in range(DEPTH):
        mixer = layer % N_MIXERS
        j = layer // N_MIXERS
        h = rmsnorm(x, norm_mix_pre[layer])
        if mixer == 0:
            m = rglru_block(h, lru_w_in[j], lru_b_in[j], lru_conv_w[j], lru_conv_b[j],
                            lru_w_ga[j], lru_b_ga[j], lru_w_gx[j], lru_b_gx[j],
                            lru_lambda[j], lru_w_out[j], lru_b_out[j])
        elif mixer == 1:
            q, k, v = split_heads(h, sb_w_qkv[j])
            m = merge_heads(stick_breaking_attention(q, k, v), sb_w_o[j])
        else:
            q, k, v = split_heads(h, moba_w_qkv[j])
            m = merge_heads(moba_attention(q, k, v, rel_bias), moba_w_o[j])
        x = x + rmsnorm(m, norm_mix_post[layer])
        h = rmsnorm(x, norm_ffn_pre[layer])
        x = x + rmsnorm(squared_relu_mlp(h, mlp_w_up[layer], mlp_w_down[layer]), norm_ffn_post[layer])
    return x
```

```cpp
#define N_LAUNCH_MODE 1
#include <hip/hip_runtime.h>
#include <cstdio>
#include <cstdint>

#define LAS __attribute__((address_space(3)))
#define GAS __attribute__((address_space(1)))
typedef unsigned short bf16;
typedef short bf16x8 __attribute__((ext_vector_type(8)));
typedef short s16x4 __attribute__((ext_vector_type(4)));
typedef float f32x2 __attribute__((ext_vector_type(2)));
typedef float f32x4 __attribute__((ext_vector_type(4)));
typedef float f32x16 __attribute__((ext_vector_type(16)));
typedef unsigned u32x2 __attribute__((ext_vector_type(2)));
typedef unsigned u32x4 __attribute__((ext_vector_type(4)));
typedef int i32x4 __attribute__((ext_vector_type(4)));

__device__ __forceinline__ unsigned cvt_pk_bf16(float lo, float hi) { unsigned r; asm volatile("v_cvt_pk_bf16_f32 %0, %1, %2" : "=v"(r) : "v"(lo), "v"(hi)); return r; }
__device__ __forceinline__ float bf_lo(unsigned w) { return __uint_as_float(w << 16); }
__device__ __forceinline__ float bf_hi(unsigned w) { return __uint_as_float(w & 0xffff0000u); }
__device__ __forceinline__ float bf2f(bf16 b) { return __uint_as_float(((unsigned)b) << 16); }
__device__ __forceinline__ float ex2(float x) { return __builtin_amdgcn_exp2f(x); }
__device__ __forceinline__ float lg2(float x) { return __builtin_amdgcn_logf(x); }
__device__ __forceinline__ float rcpf_(float x) { return __builtin_amdgcn_rcpf(x); }
constexpr float LOG2E = 1.4426950408889634f, LN2 = 0.6931471805599453f;
__device__ __forceinline__ float sigmoidf_(float v) { return rcpf_(1.0f + ex2(-v * LOG2E)); }
__device__ __forceinline__ int tid_() { int t = threadIdx.x; asm volatile("" : "+v"(t)); return t; }
__device__ __forceinline__ int bx_() { int b = blockIdx.x; asm volatile("" : "+s"(b)); return b; }
__device__ __forceinline__ int gdim_() { int g = gridDim.x; asm volatile("" : "+s"(g)); return g; }

#ifndef PG8_WGM
#define PG8_WGM 8
#endif
namespace pg8 {
constexpr int BM = 256, BK = 64, HALF = 128, HTB = HALF * BK * 2  , STAGE_BYTES = 8 * HTB, NXCD = 8, WGM = PG8_WGM;
__host__ __device__ __forceinline__ int lds_byte(int r, int c) { const int st = (r >> 4) * 2 + (c >> 5), rr = r & 15, cc = c & 31, ob = rr * 64 + cc * 2; return st * 1024 + (ob ^ (((ob >> 9) & 1) << 5)); }
__host__ __device__ __forceinline__ void stage_rc(int b, int& R, int& C) { const int st = b / 1024, sb = b % 1024, swz = sb ^ (((sb >> 9) & 1) << 5); R = (st >> 1) * 16 + swz / 64; C = (st & 1) * 32 + (swz % 64) / 2; }
__host__ __device__ __forceinline__ int perm32(int rho) { const int n = rho >> 4, i = rho & 15; return 8 * (i >> 2) + 4 * n + (i & 3); }

struct Unit { int pm, pn, ak; };
struct Gemm { const bf16* A; const bf16* Bt; int M, N, K, lda, ldb; };

struct StaticOrder {
    int nM, nN, nwg, G, c, grp;
    int akstep, wgm;
    __host__ __device__ void init(int M, int N, int G_, int c_, int grp_ = 0, int akstep_ = 0, int wgm_ = WGM) { nM = M / BM; nN = N / BM; nwg = nM * nN; G = G_; c = c_; grp = grp_; akstep = akstep_; wgm = wgm_; }
    __host__ __device__ bool next(int i, Unit& u) const {
        const long L = (long)i * G + c; if (L >= nwg) return false;
        int wgid = (int)L; { const int q = nwg / NXCD, r = nwg % NXCD, xcd = wgid % NXCD, off = wgid / NXCD; wgid = (xcd < r ? xcd * (q + 1) : r * (q + 1) + (xcd - r) * q) + off; }
        const int nig = wgm * nN, gid = wgid / nig, fm = gid * wgm, gsz = (nM - fm) < wgm ? (nM - fm) : wgm;
        u.pm = fm + ((wgid % nig) % gsz); u.pn = (wgid % nig) / gsz; u.ak = grp ? (u.pn / grp) * akstep : 0; return true;
    }
    __device__ __forceinline__ void a_ready(const Unit&) const {}
    __device__ __forceinline__ void done(const Unit&) const {}
};

__device__ __forceinline__ float gelu_tanh(float x) {
    const float u = 1.5957691216057308f * (x + 0.044715f * x * x * x);
    return x * rcpf_(1.0f + ex2(-u * LOG2E));
}
__device__ __forceinline__ f32x4 tofloat(const f32x4& v) { return v; }
__device__ __forceinline__ f32x4 tofloat(const i32x4& v) { return __builtin_convertvector(v, f32x4); }
template <int ACT> struct EpiBf16 {
    static constexpr bool PERM = true, AFTER_DRAIN = false;
    bf16* O; int ldc; const float* bias; int split_cols; size_t split_stride;
    const float* rscale; const float* cscale;
    const int* coff;
    unsigned* rowmax;
    static constexpr bool LDS_SCALES = true;
    __device__ __forceinline__ void stage_ptrs(const Unit& u, int tid, const float*& pa, const float*& pb) const {
        if (tid < 256) { pa = rscale + u.pm * BM + tid; pb = coff ? (const float*)(coff + u.pn * BM + tid) : pa; }
        else { pa = cscale + u.pn * BM + tid - 256; pb = bias ? bias + u.pn * BM + tid - 256 : pa; }
    }
    __device__ __forceinline__ bool staged() const { return cscale != nullptr; }
    template <class AV> __device__ __forceinline__ void operator()(const AV (&acc)[2][2][4][2], const Unit& u, int wr, int wc, int fr, int fq, const LAS float* sl) const {
        const int row0 = u.pm * BM + wr * 64 + fr; int colt = u.pn * BM; bf16* base = O; int t = 0;
        if (split_cols) { t = colt / split_cols; base += (size_t)t * split_stride; colt -= t * split_cols; }
        const int col0 = colt + wc * 32 + 8 * fq, lcol0 = wc * 32 + 8 * fq;
        f32x4 bv[2][2];
#pragma unroll
        for (int bj = 0; bj < 2; ++bj)
#pragma unroll
            for (int n = 0; n < 2; ++n) bv[bj][n] = !bias ? (f32x4){0.f, 0.f, 0.f, 0.f} : cscale ? *(const LAS f32x4*)(sl + 768 + lcol0 + bj * HALF + 4 * n) : *(const f32x4*)(bias + u.pn * BM + lcol0 + bj * HALF + 4 * n);
        f32x4 cs[2][2];
        if (cscale) {
#pragma unroll
            for (int bj = 0; bj < 2; ++bj)
#pragma unroll
                for (int n = 0; n < 2; ++n) cs[bj][n] = *(const LAS f32x4*)(sl + 256 + lcol0 + bj * HALF + 4 * n); }
        f32x4 co[2][2];
        if (coff) {
#pragma unroll
            for (int bj = 0; bj < 2; ++bj)
#pragma unroll
                for (int n = 0; n < 2; ++n) { const i32x4 ci = *(const LAS i32x4*)(sl + 512 + lcol0 + bj * HALF + 4 * n); co[bj][n] = __builtin_convertvector(ci, f32x4) * 128.f; } }
#pragma unroll
        for (int ai = 0; ai < 2; ++ai) { float rm4[4];
#pragma unroll
            for (int m = 0; m < 4; ++m) { bf16* rowp = base + (size_t)(row0 + ai * HALF + m * 16) * ldc + col0;
                const float rsc = cscale ? sl[wr * 64 + fr + ai * HALF + m * 16] : 1.f; float rmx = 0.f;
#pragma unroll
                for (int bj = 0; bj < 2; ++bj) { f32x4 v0 = tofloat(acc[ai][bj][m][0]), v1 = tofloat(acc[ai][bj][m][1]);
                    if (coff) { v0 = v0 + co[bj][0]; v1 = v1 + co[bj][1]; }
                    if (cscale) { v0 = v0 * rsc * cs[bj][0]; v1 = v1 * rsc * cs[bj][1]; }
                    v0 = v0 + bv[bj][0]; v1 = v1 + bv[bj][1];
                    if (ACT == 1) {
#pragma unroll
                        for (int j = 0; j < 4; ++j) { const float a = fmaxf(v0[j], 0.f), b = fmaxf(v1[j], 0.f); v0[j] = a * a; v1[j] = b * b; } }
                    if (ACT == 2) { if (t == 0) {
#pragma unroll
                        for (int j = 0; j < 4; ++j) { v0[j] = gelu_tanh(v0[j]); v1[j] = gelu_tanh(v1[j]); } } }
                    u32x4 w; w.x = cvt_pk_bf16(v0[0], v0[1]); w.y = cvt_pk_bf16(v0[2], v0[3]); w.z = cvt_pk_bf16(v1[0], v1[1]); w.w = cvt_pk_bf16(v1[2], v1[3]);
                    *(u32x4*)(rowp + bj * HALF) = w;
                    if (rowmax) rmx = fmaxf(rmx, fmaxf(fmaxf(fmaxf(v0[0], v0[1]), fmaxf(v0[2], v0[3])), fmaxf(fmaxf(v1[0], v1[1]), fmaxf(v1[2], v1[3])))); }
                if (rowmax) { rmx = fmaxf(rmx, __shfl_xor(rmx, 16)); rmx = fmaxf(rmx, __shfl_xor(rmx, 32)); rm4[m] = rmx; } }
            if (rowmax) { const float r = fq == 0 ? rm4[0] : fq == 1 ? rm4[1] : fq == 2 ? rm4[2] : rm4[3]; atomicMax(rowmax + row0 + ai * HALF + fq * 16, __float_as_uint(r)); } }
    }
};
struct EpiGate {
    static constexpr bool PERM = false, AFTER_DRAIN = false;
    const bf16* XB; bf16* LA; bf16* INP; const float* bga; const float* bgx; const float* sp8;
    static constexpr bool LDS_SCALES = false;
    __device__ __forceinline__ void stage_ptrs(const Unit&, int, const float*&, const float*&) const {}
    __device__ __forceinline__ bool staged() const { return false; }
    __device__ __forceinline__ void operator()(const f32x4 (&acc)[2][2][4][2], const Unit& u, int wr, int wc, int fr, int fq, const LAS float*) const {
        const int row0 = u.pm * BM + wr * 64 + fr; const int nb = u.pn / 3, t3 = u.pn - 3 * nb;
#pragma unroll
        for (int bj = 0; bj < 2; ++bj) {
            const int cb = 128 * t3 + 64 * bj + 16 * wc + 4 * fq;
            if (cb < 336) {
                const int c = nb * 336 + cb;
                const f32x4 ba = *(const f32x4*)(bga + c), bx = *(const f32x4*)(bgx + c), sp = *(const f32x4*)(sp8 + c);
#pragma unroll
                for (int ai = 0; ai < 2; ++ai)
#pragma unroll
                    for (int m = 0; m < 4; ++m) { const size_t row = (size_t)(row0 + ai * HALF + m * 16);
                        const u32x2 xw = *(const u32x2*)(XB + row * 6144 + nb * 384 + cb);
                        const float xb[4] = {bf_lo(xw.x), bf_hi(xw.x), bf_lo(xw.y), bf_hi(xw.y)};
                        float la[4], ip[4];
#pragma unroll
                        for (int j = 0; j < 4; ++j) { const float r = sigmoidf_(acc[ai][bj][m][0][j] + ba[j]), ig = sigmoidf_(acc[ai][bj][m][1][j] + bx[j]);
                            const float l = -r * sp[j]; la[j] = l; const float x2 = 2.f * l;
                            float p = 1.f + x2 * (1.f / 6.f); p = 1.f + x2 * 0.2f * p; p = 1.f + x2 * 0.25f * p; p = 1.f + x2 * (1.f / 3.f) * p; p = 1.f + x2 * 0.5f * p;
                            const float om = x2 > -0.3f ? -x2 * p : 1.f - ex2(x2 * LOG2E);
                            ip[j] = __builtin_amdgcn_sqrtf(fmaxf(om, 0.f)) * ig * xb[j]; }
                        u32x2 wl, wi; wl.x = cvt_pk_bf16(la[0], la[1]); wl.y = cvt_pk_bf16(la[2], la[3]); wi.x = cvt_pk_bf16(ip[0], ip[1]); wi.y = cvt_pk_bf16(ip[2], ip[3]);
                        *(u32x2*)(LA + row * 5376 + c) = wl; *(u32x2*)(INP + row * 5376 + c) = wi; }
            }
        }
    }
};

template <bool I8> struct AccT { typedef f32x4 type; };
template <> struct AccT<true> { typedef i32x4 type; };
constexpr int EPI_SL_OFF = 131072 + 4096;
template <class Epi, class Sched, bool ALIGN_EPI = true, bool I8 = false>
__device__ __forceinline__ void gemm_phase(LAS unsigned char* lds, const Gemm g, const Sched& S, const Epi& E) {
    const int tid = tid_(), wid = __builtin_amdgcn_readfirstlane(tid >> 6), lane = tid & 63, wr = wid >> 2, wc = wid & 3, fr = lane & 15, fq = lane >> 4;
    const int K = g.K, nt = K / BK;
    unsigned voffA[2], voffB[2];
#pragma unroll
    for (int i = 0; i < 2; ++i) { int R, C; stage_rc(tid * 16 + i * 8192, R, C); const int Rb = Epi::PERM ? ((R & ~31) + perm32(R & 31)) : R;
        voffA[i] = (unsigned)(R * g.lda + C) * 2u; voffB[i] = (unsigned)(Rb * g.ldb + C) * 2u; }
    const size_t kstep = (size_t)(BK * 2);
    const size_t hA = (size_t)HALF * g.lda * 2, hB = (size_t)HALF * g.ldb * 2;
    const size_t tA = 2 * hA, tB = 2 * hB;
    const unsigned ldsw = (unsigned)wid * 1024u;
    const int aoff = lds_byte(wr * 64 + fr, fq * 8), boff = lds_byte(wc * 32 + fr, fq * 8);
#define PG8_SA(b, h) (((b) * 2 + (h)) * HTB)
#define PG8_SB(b, h) ((4 + (b) * 2 + (h)) * HTB)
#define PG8_STAGE(bufoff, gbase, voff) do { _Pragma("unroll") for (int _i = 0; _i < 2; ++_i) \
        __builtin_amdgcn_global_load_lds((const unsigned*)((const char*)(gbase) + (voff)[_i]), (LAS unsigned*)(lds + (bufoff) + ldsw + _i * 8192), 16, 0, 0); } while (0)
#define PG8_LDA(dst, b, h) do { _Pragma("unroll") for (int m = 0; m < 4; ++m) _Pragma("unroll") for (int k = 0; k < 2; ++k) dst[m][k] = *(const LAS bf16x8*)(lds + PG8_SA(b, h) + aoff + m * 2048 + k * 1024); } while (0)
#define PG8_LDB(dst, b, h) do { _Pragma("unroll") for (int n = 0; n < 2; ++n) _Pragma("unroll") for (int k = 0; k < 2; ++k) dst[n][k] = *(const LAS bf16x8*)(lds + PG8_SB(b, h) + boff + n * 2048 + k * 1024); } while (0)
#define PG8_MMA(ai, bj, At, Bt) do { __builtin_amdgcn_s_setprio(1); _Pragma("unroll") for (int m = 0; m < 4; ++m) _Pragma("unroll") for (int n = 0; n < 2; ++n) _Pragma("unroll") for (int k = 0; k < 2; ++k) \
        { if constexpr (I8) acc[ai][bj][m][n] = __builtin_amdgcn_mfma_i32_16x16x64_i8(__builtin_bit_cast(i32x4, Bt[n][k]), __builtin_bit_cast(i32x4, At[m][k]), acc[ai][bj][m][n], 0, 0, 0); \
          else acc[ai][bj][m][n] = __builtin_amdgcn_mfma_f32_16x16x32_bf16(Bt[n][k], At[m][k], acc[ai][bj][m][n], 0, 0, 0); } __builtin_amdgcn_s_setprio(0); } while (0)
#define PG8_WAIT_V(n) asm volatile("s_waitcnt vmcnt(" #n ")" ::: "memory")
#define PG8_WAIT_L(n) asm volatile("s_waitcnt lgkmcnt(" #n ")" ::: "memory")
#define PG8_BAR __builtin_amdgcn_s_barrier()
#define PG8_SCHED __builtin_amdgcn_sched_barrier(0)
    Unit cur, nxt; int ui = 0;
    if (!S.next(0, cur)) return;
    LAS float* sl = (LAS float*)(lds + EPI_SL_OFF); float sva = 1.f, svb = 0.f;
    typedef typename AccT<I8>::type accv;
    accv acc[2][2][4][2];
#pragma unroll
    for (int a = 0; a < 2; ++a)
#pragma unroll
        for (int b = 0; b < 2; ++b)
#pragma unroll
            for (int m = 0; m < 4; ++m)
#pragma unroll
                for (int n = 0; n < 2; ++n) acc[a][b][m][n] = accv{};
    bf16x8 At[4][2], B0[2][2], B1[2][2];
    const char* cA = (const char*)g.A + (size_t)cur.pm * tA + (size_t)cur.ak * 2; const char* cB = (const char*)g.Bt + (size_t)cur.pn * tB;
    S.a_ready(cur);
    PG8_STAGE(PG8_SB(0, 0), cB, voffB); PG8_STAGE(PG8_SB(0, 1), cB + hB, voffB); PG8_STAGE(PG8_SA(0, 0), cA, voffA); PG8_STAGE(PG8_SA(0, 1), cA + hA, voffA);
    if (wr == 1) PG8_BAR;
    PG8_WAIT_V(2); PG8_BAR;
    PG8_STAGE(PG8_SB(1, 0), cB + kstep, voffB); PG8_STAGE(PG8_SA(1, 0), cA + kstep, voffA); PG8_STAGE(PG8_SB(1, 1), cB + hB + kstep, voffB);
    PG8_WAIT_V(6); PG8_BAR;
    for (;;) {
        const bool has_next = S.next(ui + 1, nxt);
        const char* nA = has_next ? (const char*)g.A + (size_t)nxt.pm * tA + (size_t)nxt.ak * 2 : cA; const char* nB = has_next ? (const char*)g.Bt + (size_t)nxt.pn * tB : cB;
        if constexpr (Epi::LDS_SCALES) { if (E.staged()) { const float* pa; const float* pb; E.stage_ptrs(cur, tid, pa, pb);
            asm volatile("global_load_dword %0, %2, off\n\tglobal_load_dword %1, %3, off" : "=&v"(sva), "=&v"(svb) : "v"(pa), "v"(pb) : "memory"); } }
#pragma nounroll
        for (int t = 0; t < nt; t += 2) {
            const bool last = (t == nt - 2);
            const char* a1 = cA + (size_t)(t + 1) * kstep;
            const char* a2 = last ? nA : cA + (size_t)(t + 2) * kstep; const char* b2 = last ? nB : cB + (size_t)(t + 2) * kstep;
            const char* a3 = a2 + kstep; const char* b3 = b2 + kstep;
            if (last && has_next) S.a_ready(nxt);
            PG8_LDB(B0, 0, 0); PG8_LDB(B1, 0, 1); PG8_SCHED; PG8_LDA(At, 0, 0); PG8_STAGE(PG8_SA(1, 1), a1 + hA, voffA);
            PG8_WAIT_V(8); PG8_WAIT_L(0); PG8_BAR; PG8_MMA(0, 0, At, B0); PG8_MMA(0, 1, At, B1); PG8_BAR; PG8_SCHED;
            PG8_LDA(At, 0, 1); PG8_STAGE(PG8_SB(0, 0), b2, voffB); PG8_STAGE(PG8_SB(0, 1), b2 + hB, voffB); PG8_STAGE(PG8_SA(0, 0), a2, voffA);
            PG8_WAIT_V(8); PG8_WAIT_L(0); PG8_BAR; PG8_MMA(1, 0, At, B0); PG8_MMA(1, 1, At, B1); PG8_BAR; PG8_SCHED;
            PG8_LDB(B0, 1, 0); PG8_LDB(B1, 1, 1); PG8_SCHED; PG8_LDA(At, 1, 0); PG8_STAGE(PG8_SA(0, 1), a2 + hA, voffA);
            PG8_WAIT_V(8); PG8_WAIT_L(0); PG8_BAR; PG8_MMA(0, 0, At, B0); PG8_MMA(0, 1, At, B1); PG8_BAR; PG8_SCHED;
            PG8_LDA(At, 1, 1); PG8_STAGE(PG8_SB(1, 0), b3, voffB); PG8_STAGE(PG8_SB(1, 1), b3 + hB, voffB); PG8_STAGE(PG8_SA(1, 0), a3, voffA);
            PG8_WAIT_V(8); PG8_WAIT_L(0); PG8_BAR; PG8_MMA(1, 0, At, B0); PG8_MMA(1, 1, At, B1); PG8_BAR; PG8_SCHED;
            if constexpr (Epi::LDS_SCALES) { sl[tid] = sva; sl[512 + tid] = svb; }
        }
        if constexpr (ALIGN_EPI) { if (wr == 0) PG8_BAR; }
        E(acc, cur, wr, wc, fr, fq, sl); S.done(cur);
        if (!has_next) break;
#pragma unroll
        for (int a = 0; a < 2; ++a)
#pragma unroll
            for (int b = 0; b < 2; ++b)
#pragma unroll
                for (int m = 0; m < 4; ++m)
#pragma unroll
                    for (int n = 0; n < 2; ++n) acc[a][b][m][n] = accv{};
        cur = nxt; cA = nA; cB = nB; ++ui;
        if constexpr (ALIGN_EPI) { if (wr == 1) PG8_BAR; }
    }
    PG8_WAIT_V(0);
    if constexpr (!ALIGN_EPI) { if (wr == 0) PG8_BAR; }
    PG8_BAR;
#undef PG8_SA
#undef PG8_SB
#undef PG8_STAGE
#undef PG8_LDA
#undef PG8_LDB
#undef PG8_MMA
#undef PG8_WAIT_V
#undef PG8_WAIT_L
#undef PG8_BAR
#undef PG8_SCHED
}
}
constexpr int BATCH = 4, SEQ = 4096, D = 4096, NH = 32, HD = 128, FF = 16384, DEPTH = 4;
constexpr int M = BATCH * SEQ;
constexpr int RW = 5376, NBLK = 16, BW = 336, BWP = 384, RWP = NBLK * BWP;
constexpr int NGATE = NBLK * 768;
constexpr int CHUNK = 64, NCHUNK = SEQ / CHUNK;
constexpr float EPS = 1e-6f;
constexpr int NWAVES = 8, NTHREADS = 512;

constexpr size_t MiB = 1u << 20;
constexpr size_t WS_CTL = 0, CTL_ZERO_BYTES = 2 * MiB;
constexpr size_t WS_WLIN = 2 * MiB;
constexpr size_t WS_WLOUT = WS_WLIN + 168 * MiB;
constexpr size_t WS_WGATE = WS_WLOUT + 84 * MiB;
constexpr size_t WS_WSQKV = WS_WGATE + 18 * MiB;
constexpr size_t WS_WSO = WS_WSQKV + 96 * MiB;
constexpr size_t WS_WMQKV = WS_WSO + 32 * MiB;
constexpr size_t WS_WMO = WS_WMQKV + 96 * MiB;
constexpr size_t WS_WUP = WS_WMO + 32 * MiB;
constexpr size_t WS_WDN = WS_WUP + 512 * MiB;
constexpr size_t WS_SP8 = WS_WDN + 512 * MiB;
constexpr size_t WS_WSCALE_WO = WS_SP8 + 320 * 1024;
constexpr size_t WS_WSCALE_MKV = WS_SP8 + 128 * 1024;
constexpr size_t WS_WSCALE_SQKV = WS_SP8 + 64 * 1024;
constexpr size_t WS_WSCALE_DN = WS_SP8 + 896 * 1024;
constexpr size_t WS_ASCALE = WS_SP8 + 192 * 1024;
constexpr size_t WS_WSCALE_LIN = WS_SP8 + 768 * 1024;
constexpr size_t WS_HSCALE = WS_SP8 + 256 * 1024, WS_WSCALE = WS_SP8 + 512 * 1024;
constexpr size_t WS_HB = WS_SP8 + 1 * MiB;
constexpr size_t WS_MX = WS_HB + 128 * MiB;
constexpr size_t WS_SCR = WS_MX + 128 * MiB;
constexpr size_t SCR_UQ = 512 * MiB;
constexpr size_t SCR_U = 0;
constexpr size_t SCR_G = 0, SCR_XP = 168 * MiB, SCR_XB = 336 * MiB, SCR_LA = 528 * MiB, SCR_INP = 696 * MiB, SCR_Y = 864 * MiB;
constexpr size_t SCR_SUML = 1032 * MiB, SCR_HEND = 1038 * MiB;
constexpr size_t SCR_Q = 0, SCR_K = 128 * MiB, SCR_V = 256 * MiB, SCR_O = 384 * MiB;
constexpr size_t SCR_OQ = 520 * MiB;
constexpr size_t SCR_KMH = 512 * MiB, SCR_KML = 513 * MiB;
constexpr size_t WS_X16 = WS_SCR + 1044 * MiB;
constexpr size_t WS_HQ2 = WS_X16 + 128 * MiB;
constexpr size_t WS_YQ = WS_HQ2 + 64 * MiB;
constexpr size_t WS_END = WS_YQ + 96 * MiB;

constexpr int CW_BAR = 4096;
constexpr int CW_COLMAX_DN = 122880, CW_CS_DN = 139264, CW_ROWMAX = 155648;
constexpr int CW_COLMAX_WO = 241664;
constexpr int CW_COLMAX_MKV = 262144;
constexpr int CW_COLMAX_SQKV = 221184;
constexpr int CW_COLMAX_LIN = 98304;
constexpr int CW_COLMAX = 32768;
constexpr int CW_DYN = 8192;
constexpr int CW_DEAL = 294912;
constexpr int CW_ERR = 16384;

constexpr int RING_BYTES = 131072;
constexpr int LDSCTL_OFF = RING_BYTES;
constexpr int LDS_DYN = LDSCTL_OFF + 8192;
static_assert(pg8::EPI_SL_OFF == LDSCTL_OFF + 4096, "epilogue scale area");
constexpr int LDS_BYTES = 147456;

#define VM_WAIT() asm volatile("s_waitcnt vmcnt(0)" ::: "memory")
#define LDS_WAIT() asm volatile("s_waitcnt lgkmcnt(0)" ::: "memory")

#define XB_TMO      128
#define XB_XCNT(j)  (256  + 64 * (j))
#define XB_XSUB(j)  (1280 + 64 * (j))
#define XB_XGEN(j)  (2304 + 64 * (j))
#define XB_TOP      3328
#define XB_TOPGEN   3392
#define XCD_BAR_WORDS 3456
#define XB_SPIN_CAP (1u << 18)
__device__ __forceinline__ unsigned xb_ld(unsigned* p)              { return __hip_atomic_load(p, __ATOMIC_RELAXED, __HIP_MEMORY_SCOPE_AGENT); }
__device__ __forceinline__ unsigned xb_add(unsigned* p, unsigned v) { return __hip_atomic_fetch_add(p, v, __ATOMIC_RELAXED, __HIP_MEMORY_SCOPE_AGENT); }
__device__ __forceinline__ unsigned xb_xcc_id() { return (unsigned)__builtin_amdgcn_s_getreg((3 << 11) | 20) & 0xFu; }
#define XB_SPIN(cond, bar) do { unsigned _sp = 0; while (cond) { __builtin_amdgcn_s_sleep(1); \
    if ((++_sp & 255u) == 0u) { if (xb_ld(&(bar)[XB_TMO])) break; if (_sp > XB_SPIN_CAP) { atomicAdd(&(bar)[XB_TMO], 1u); break; } } } } while (0)
struct XcdBarrier { unsigned* bar; unsigned x; volatile LAS unsigned* st; };
__device__ __forceinline__ XcdBarrier xcd_barrier_post(unsigned* bar, volatile LAS unsigned* st) {
    XcdBarrier b; b.bar = bar; b.x = xb_xcc_id(); b.st = st;
    if (threadIdx.x == 0) (void)xb_add(&bar[XB_XCNT(b.x)], 1u);
    return b;
}
__device__ __forceinline__ void xcd_barrier_complete(unsigned* bar, unsigned x, unsigned& nloc, unsigned& nx) {
    const unsigned G = gridDim.x * gridDim.y * gridDim.z;
    unsigned sum, cnt, mine, sp = 0u;
    for (;;) {
        sum = 0u; cnt = 0u; mine = 0u;
#pragma unroll
        for (unsigned j = 0; j < 16; ++j) { const unsigned c = xb_ld(&bar[XB_XCNT(j)]); sum += c; cnt += (c > 0u) ? 1u : 0u; mine = (j == x) ? c : mine; }
        if (sum == G) break;
        __builtin_amdgcn_s_sleep(1);
        if ((++sp & 255u) == 0u) { if (xb_ld(&bar[XB_TMO])) break; if (sp > XB_SPIN_CAP) { atomicAdd(&bar[XB_TMO], 1u); break; } }
    }
    nloc = mine > 0u ? mine : 1u; nx = cnt > 0u ? cnt : 1u;
}
__device__ __forceinline__ void xcd_barrier(const XcdBarrier& b) {
    asm volatile("s_waitcnt vmcnt(0)" ::: "memory");
    __syncthreads();
    if (threadIdx.x == 0) {
        unsigned* bar = b.bar;
        __builtin_amdgcn_s_waitcnt(0);
        unsigned nloc = b.st[0], nx = b.st[1];
        if (nloc == 0u) { xcd_barrier_complete(bar, b.x, nloc, nx); b.st[0] = nloc; b.st[1] = nx; }
        const unsigned old = xb_add(&bar[XB_XSUB(b.x)], 1u);
        const unsigned gen = old / nloc;
        if (old + 1u == (gen + 1u) * nloc) {
            __builtin_amdgcn_fence(__ATOMIC_RELEASE, "agent");
            asm volatile("s_waitcnt vmcnt(0)" ::: "memory");
            const unsigned og = xb_add(&bar[XB_TOP], 1u);
            const unsigned tg = og / nx;
            if (og + 1u == (tg + 1u) * nx) xb_add(&bar[XB_TOPGEN], 1u);
            else XB_SPIN(xb_ld(&bar[XB_TOPGEN]) == tg, bar);
            __builtin_amdgcn_fence(__ATOMIC_ACQUIRE, "agent");
            xb_add(&bar[XB_XGEN(b.x)], 1u);
            asm volatile("s_waitcnt vmcnt(0)" ::: "memory");
        } else {
            XB_SPIN(xb_ld(&bar[XB_XGEN(b.x)]) == gen, bar);
            __builtin_amdgcn_fence(__ATOMIC_ACQUIRE, "agent");
            asm volatile("s_waitcnt vmcnt(0)" ::: "memory");
        }
    }
    __syncthreads();
}

__device__ __forceinline__ float wave_sum(float v) {
#pragma unroll
    for (int o = 1; o < 64; o <<= 1) v += __shfl_xor(v, o);
    return v;
}
struct Deal { unsigned* cnt; int g, ngrp, wi, nw; };
__device__ __forceinline__ Deal deal_make(unsigned* ctl, int site, int bx, int G, int wave) {
    Deal d; d.g = min(bx >> 3, 31); d.ngrp = min((G + 7) >> 3, 32); d.cnt = ctl + CW_DEAL + (site * 32 + d.g) * 16; d.wi = (bx - d.g * 8) * NWAVES + wave; d.nw = (d.g == d.ngrp - 1 ? G - d.g * 8 : 8) * NWAVES; return d;
}
__device__ __forceinline__ unsigned deal_issue(const Deal& d, int lane) { unsigned v = 0u; if (lane == 0) v = __hip_atomic_fetch_add(d.cnt, 1u, __ATOMIC_RELAXED, __HIP_MEMORY_SCOPE_AGENT); return v; }
constexpr int QCH = 4;
#define TILE_LOAD(dst, itm) do { const int kb_ = (itm) / nblk, nb_ = (itm) % nblk; const float* wp_ = W + (size_t)(64 * kb_ + (lane >> 5)) * ldw + 32 * nb_ + (lane & 31); \
        _Pragma("unroll") for (int i_ = 0; i_ < 32; ++i_) dst[i_] = wp_[(size_t)(2 * i_) * ldw]; } while (0)
__device__ __forceinline__ void transpose_matrix(const float* W, int K, int N, bf16* WT, LAS float* scr, const Deal d, int lane, int ldw = 0) {
    const int nblk = N / 32, nitems = (K / 64) * nblk; if (ldw == 0) ldw = N;
    int item = (d.wi * d.ngrp + d.g) * QCH; if (item >= nitems) return;
    float tv[32], tn[32]; TILE_LOAD(tv, item);
    unsigned tk = deal_issue(d, lane);
    for (;;) {
        int nxt = item + 1;
        if (nxt % QCH == 0) { nxt = (((int)__builtin_amdgcn_readfirstlane(tk) + d.nw) * d.ngrp + d.g) * QCH; if (nxt < nitems) tk = deal_issue(d, lane); }
        const int kb = item / nblk, nb = item % nblk, k0 = 64 * kb, n0 = 32 * nb; const bool more = nxt < nitems;
        if (more) TILE_LOAD(tn, nxt);
#pragma unroll
        for (int i = 0; i < 32; ++i) scr[(2 * i + (lane >> 5)) * 33 + (lane & 31)] = tv[i];
        LDS_WAIT(); asm volatile("" ::: "memory");
        const int c = lane & 7;
#pragma unroll
        for (int j = 0; j < 4; ++j) { const int n = (lane >> 3) + 8 * j; const LAS float* s = scr + (8 * c) * 33 + n;
            u32x4 o; o.x = cvt_pk_bf16(s[0 * 33], s[1 * 33]); o.y = cvt_pk_bf16(s[2 * 33], s[3 * 33]); o.z = cvt_pk_bf16(s[4 * 33], s[5 * 33]); o.w = cvt_pk_bf16(s[6 * 33], s[7 * 33]);
            *(GAS u32x4*)(WT + (size_t)(n0 + n) * K + k0 + 8 * c) = o; }
        LDS_WAIT(); asm volatile("" ::: "memory");
        if (!more) break;
#pragma unroll
        for (int i = 0; i < 32; ++i) tv[i] = tn[i];
        item = nxt;
    }
}
__device__ __forceinline__ void norm_row(const float* xrow, const float* g, bf16* orow, int lane) {
    const GAS f32x4* xr = (const GAS f32x4*)xrow + lane; const GAS f32x4* gr = (const GAS f32x4*)g + lane;
    f32x4 v[16]; float s = 0.f;
#pragma unroll
    for (int j = 0; j < 16; ++j) { v[j] = xr[64 * j]; s += (v[j].x * v[j].x + v[j].y * v[j].y) + (v[j].z * v[j].z + v[j].w * v[j].w); }
    const float rs = 1.0f / sqrtf(wave_sum(s) * (1.f / D) + EPS);
    GAS u32x2* o8 = (GAS u32x2*)orow + lane;
#pragma unroll
    for (int j = 0; j < 16; ++j) { const f32x4 gg = gr[64 * j]; u32x2 w; w.x = cvt_pk_bf16(v[j].x * rs * gg.x, v[j].y * rs * gg.y); w.y = cvt_pk_bf16(v[j].z * rs * gg.z, v[j].w * rs * gg.w); o8[64 * j] = w; }
}
__device__ __forceinline__ void norm_row_q(const float* xrow, const float* g, signed char* orow, float* hscale_m, int lane) {
    const GAS f32x4* xr = (const GAS f32x4*)xrow + lane; const GAS f32x4* gr = (const GAS f32x4*)g + lane;
    f32x4 v[16]; float s = 0.f;
#pragma unroll
    for (int j = 0; j < 16; ++j) { v[j] = xr[64 * j]; s += (v[j].x * v[j].x + v[j].y * v[j].y) + (v[j].z * v[j].z + v[j].w * v[j].w); }
    const float rs = 1.0f / sqrtf(wave_sum(s) * (1.f / D) + EPS); float am = 0.f;
#pragma unroll
    for (int j = 0; j < 16; ++j) { const f32x4 gg = gr[64 * j]; v[j] = v[j] * rs * gg; am = fmaxf(am, fmaxf(fmaxf(fabsf(v[j].x), fabsf(v[j].y)), fmaxf(fabsf(v[j].z), fabsf(v[j].w)))); }
#pragma unroll
    for (int o = 1; o < 64; o <<= 1) am = fmaxf(am, __shfl_xor(am, o));
    const float inv = am > 0.f ? 127.f / am : 0.f; GAS unsigned* o4 = (GAS unsigned*)orow + lane;
#pragma unroll
    for (int j = 0; j < 16; ++j) { const int a = (int)rintf(v[j].x * inv) & 0xff, b = (int)rintf(v[j].y * inv) & 0xff, c = (int)rintf(v[j].z * inv) & 0xff, d = (int)rintf(v[j].w * inv) & 0xff; o4[64 * j] = (unsigned)(a | (b << 8) | (c << 16) | (d << 24)); }
    if (lane == 0) *hscale_m = am * (1.f / 127.f);
}
template <int HMODE, bool XIN32, bool XOUT32> __device__ __forceinline__ void phase_res(LAS unsigned char* lds, const void* xin, const bf16* mx, const float* gpost, void* xout, const float* gnext, bf16* hb, signed char* hq, float* hscale) {
    const int tid = tid_(), lane = tid & 63, gw = bx_() * NWAVES + (tid >> 6), ngw = gdim_() * NWAVES;
    LAS f32x4* gp = (LAS f32x4*)lds; LAS f32x4* gn = (LAS f32x4*)(lds + 16384);
    for (int i = tid; i < D / 4; i += NTHREADS) { gp[i] = ((const GAS f32x4*)gpost)[i]; if (HMODE != 0) gn[i] = ((const GAS f32x4*)gnext)[i]; }
    __syncthreads();
    for (int m = gw; m < M; m += ngw) {
        const GAS u32x2* mr = (const GAS u32x2*)(mx + (size_t)m * D) + lane;
        u32x2 mw[16]; f32x4 v[16];
#pragma unroll
        for (int j = 0; j < 16; ++j) mw[j] = mr[64 * j];
        if constexpr (XIN32) { const GAS f32x4* xr = (const GAS f32x4*)((const float*)xin + (size_t)m * D) + lane;
#pragma unroll
            for (int j = 0; j < 16; ++j) v[j] = xr[64 * j]; }
        else { const GAS u32x2* xr = (const GAS u32x2*)((const bf16*)xin + (size_t)m * D) + lane;
#pragma unroll
            for (int j = 0; j < 16; ++j) { const u32x2 w = xr[64 * j]; v[j] = (f32x4){bf_lo(w.x), bf_hi(w.x), bf_lo(w.y), bf_hi(w.y)}; } }
        float s = 0.f;
#pragma unroll
        for (int j = 0; j < 16; ++j) { const float a = bf_lo(mw[j].x), b = bf_hi(mw[j].x), c = bf_lo(mw[j].y), d = bf_hi(mw[j].y); s += (a * a + b * b) + (c * c + d * d); }
        const float rs = 1.0f / sqrtf(wave_sum(s) * (1.f / D) + EPS);
        float s2 = 0.f;
#pragma unroll
        for (int j = 0; j < 16; ++j) { const f32x4 gg = gp[64 * j + lane]; const f32x4 mm = (f32x4){bf_lo(mw[j].x), bf_hi(mw[j].x), bf_lo(mw[j].y), bf_hi(mw[j].y)};
            v[j] = v[j] + mm * rs * gg;
            if constexpr (XOUT32) { ((GAS f32x4*)((float*)xout + (size_t)m * D) + lane)[64 * j] = v[j]; }
            else { u32x2 w; w.x = cvt_pk_bf16(v[j].x, v[j].y); w.y = cvt_pk_bf16(v[j].z, v[j].w); ((GAS u32x2*)((bf16*)xout + (size_t)m * D) + lane)[64 * j] = w;
                   v[j] = (f32x4){bf_lo(w.x), bf_hi(w.x), bf_lo(w.y), bf_hi(w.y)}; }
            s2 += (v[j].x * v[j].x + v[j].y * v[j].y) + (v[j].z * v[j].z + v[j].w * v[j].w);
            if ((j & 3) == 3) asm volatile("" ::: "memory"); }
        if constexpr (HMODE == 1) {
            const float rs2 = 1.0f / sqrtf(wave_sum(s2) * (1.f / D) + EPS);
            GAS u32x2* o8 = (GAS u32x2*)(hb + (size_t)m * D) + lane;
#pragma unroll
            for (int j = 0; j < 16; ++j) { const f32x4 gg = gn[64 * j + lane]; u32x2 w; w.x = cvt_pk_bf16(v[j].x * rs2 * gg.x, v[j].y * rs2 * gg.y); w.y = cvt_pk_bf16(v[j].z * rs2 * gg.z, v[j].w * rs2 * gg.w); o8[64 * j] = w; if ((j & 3) == 3) asm volatile("" ::: "memory"); }
        }
        if constexpr (HMODE == 2 || HMODE == 3) {
            const float rs2 = 1.0f / sqrtf(wave_sum(s2) * (1.f / D) + EPS); float am = 0.f;
#pragma unroll
            for (int j = 0; j < 16; ++j) { const f32x4 gg = gn[64 * j + lane]; v[j] = v[j] * rs2 * gg;
                if constexpr (HMODE == 3) { u32x2 w; w.x = cvt_pk_bf16(v[j].x, v[j].y); w.y = cvt_pk_bf16(v[j].z, v[j].w); ((GAS u32x2*)(hb + (size_t)m * D) + lane)[64 * j] = w; } am = fmaxf(am, fmaxf(fmaxf(fabsf(v[j].x), fabsf(v[j].y)), fmaxf(fabsf(v[j].z), fabsf(v[j].w)))); if ((j & 3) == 3) asm volatile("" ::: "memory"); }
#pragma unroll
            for (int o = 1; o < 64; o <<= 1) am = fmaxf(am, __shfl_xor(am, o));
            const float inv = am > 0.f ? 127.f / am : 0.f; GAS unsigned* o4 = (GAS unsigned*)(hq + (size_t)m * D) + lane;
#pragma unroll
            for (int j = 0; j < 16; ++j) { const int a = (int)rintf(v[j].x * inv) & 0xff, b = (int)rintf(v[j].y * inv) & 0xff, c = (int)rintf(v[j].z * inv) & 0xff, d = (int)rintf(v[j].w * inv) & 0xff; o4[64 * j] = (unsigned)(a | (b << 8) | (c << 16) | (d << 24)); }
            if (lane == 0) hscale[m] = am * (1.f / 127.f);
        }
    }
    __syncthreads();
}
__device__ __forceinline__ void gate_weights(const float* wga, const float* wgx, bf16* WG) {
    const size_t n = (size_t)NGATE * BWP;
    for (size_t i = (size_t)bx_() * NTHREADS + tid_(); i < n; i += (size_t)gdim_() * NTHREADS) {
        const int jr = (int)(i / BWP), k = (int)(i % BWP); const int nb = jr / 768, jj = jr % 768;
        const int t3 = jj / 256, bj = (jj % 256) / 128, wc = (jj % 128) / 32, gate = (jj % 32) / 16, q = jj % 16; const int ch = 128 * t3 + 64 * bj + 16 * wc + q;
        float v = 0.f; if (k < BW && ch < BW) v = (gate ? wgx : wga)[((size_t)nb * BW + k) * BW + ch];
        WG[i] = (bf16)(cvt_pk_bf16(v, 0.f) & 0xffffu);
    }
}
__device__ __forceinline__ void phase_conv(const bf16* XP, const float* cw, const float* cb, bf16* XB) {
    constexpr int NCH = RWP / 8;
    const int nitems = (M / 16) * NCH;
    for (int it = bx_() * NTHREADS + tid_(); it < nitems; it += gdim_() * NTHREADS) {
        const int ch = it % NCH, tg = it / NCH, m0 = tg * 16, nb = ch / 48, cc0 = (ch % 48) * 8;
        bf16* out = XB + (size_t)m0 * RWP + nb * BWP + cc0;
        if (cc0 >= BW) { for (int r = 0; r < 16; ++r) *(u32x4*)(out + (size_t)r * RWP) = (u32x4){0u, 0u, 0u, 0u}; continue; }
        const int c0 = nb * BW + cc0, t0 = m0 % SEQ;
        float w[4][8], bb[8];
#pragma unroll
        for (int k = 0; k < 4; ++k) { const f32x4 a = *(const f32x4*)(cw + (size_t)k * RW + c0), b = *(const f32x4*)(cw + (size_t)k * RW + c0 + 4);
            w[k][0] = a.x; w[k][1] = a.y; w[k][2] = a.z; w[k][3] = a.w; w[k][4] = b.x; w[k][5] = b.y; w[k][6] = b.z; w[k][7] = b.w; }
        { const f32x4 a = *(const f32x4*)(cb + c0), b = *(const f32x4*)(cb + c0 + 4); bb[0] = a.x; bb[1] = a.y; bb[2] = a.z; bb[3] = a.w; bb[4] = b.x; bb[5] = b.y; bb[6] = b.z; bb[7] = b.w; }
        u32x4 xv[19];
#pragma unroll
        for (int r = 0; r < 19; ++r) xv[r] = (t0 + r - 3 < 0) ? (u32x4){0u, 0u, 0u, 0u} : *(const u32x4*)(XP + (size_t)(m0 + r - 3) * RW + c0);
#pragma unroll
        for (int r = 0; r < 16; ++r) { float y[8];
#pragma unroll
            for (int j = 0; j < 8; ++j) { const int wsel = j >> 1; float x4[4];
#pragma unroll
                for (int k = 0; k < 4; ++k) { const unsigned wd = wsel == 0 ? xv[r + k].x : wsel == 1 ? xv[r + k].y : wsel == 2 ? xv[r + k].z : xv[r + k].w; x4[k] = (j & 1) ? bf_hi(wd) : bf_lo(wd); }
                y[j] = bb[j] + w[0][j] * x4[0] + w[1][j] * x4[1] + w[2][j] * x4[2] + w[3][j] * x4[3]; }
            u32x4 o; o.x = cvt_pk_bf16(y[0], y[1]); o.y = cvt_pk_bf16(y[2], y[3]); o.z = cvt_pk_bf16(y[4], y[5]); o.w = cvt_pk_bf16(y[6], y[7]);
            *(u32x4*)(out + (size_t)r * RWP) = o; }
    }
}
__device__ __forceinline__ void phase_scan1(const bf16* LA, const bf16* INP, float* SUML, float* HEND) {
    constexpr int NC4 = RW / 4; const int nitems = BATCH * NCHUNK * NC4;
    for (int it = bx_() * NTHREADS + tid_(); it < nitems; it += gdim_() * NTHREADS) {
        const int c4 = it % NC4, bc = it / NC4, c = c4 * 4; const size_t m0 = (size_t)bc * CHUNK;
        float sl[4] = {0.f, 0.f, 0.f, 0.f}, h[4] = {0.f, 0.f, 0.f, 0.f};
#pragma unroll 16
        for (int r = 0; r < CHUNK; ++r) { const u32x2 lw = *(const u32x2*)(LA + (m0 + r) * RW + c), iw = *(const u32x2*)(INP + (m0 + r) * RW + c);
            const float l[4] = {bf_lo(lw.x), bf_hi(lw.x), bf_lo(lw.y), bf_hi(lw.y)}, in[4] = {bf_lo(iw.x), bf_hi(iw.x), bf_lo(iw.y), bf_hi(iw.y)};
#pragma unroll
            for (int j = 0; j < 4; ++j) { sl[j] += l[j]; h[j] = ex2(l[j] * LOG2E) * h[j] + in[j]; } }
        *(f32x4*)(SUML + (size_t)bc * RW + c) = (f32x4){sl[0], sl[1], sl[2], sl[3]}; *(f32x4*)(HEND + (size_t)bc * RW + c) = (f32x4){h[0], h[1], h[2], h[3]};
    }
}
__device__ __forceinline__ void phase_scan2(const bf16* LA, const bf16* INP, const float* SUML, const float* HEND, const bf16* G, bf16* Y) {
    constexpr int NC4 = RW / 4; const int nitems = BATCH * NCHUNK * NC4;
    for (int it = bx_() * NTHREADS + tid_(); it < nitems; it += gdim_() * NTHREADS) {
        const int c4 = it % NC4, bc = it / NC4, c = c4 * 4, b = bc / NCHUNK, ci = bc % NCHUNK; const size_t m0 = (size_t)bc * CHUNK;
        float h[4] = {0.f, 0.f, 0.f, 0.f};
#pragma unroll 8
        for (int cj = 0; cj < ci; ++cj) { const f32x4 s = *(const f32x4*)(SUML + (size_t)(b * NCHUNK + cj) * RW + c), e = *(const f32x4*)(HEND + (size_t)(b * NCHUNK + cj) * RW + c);
            h[0] = ex2(s.x * LOG2E) * h[0] + e.x; h[1] = ex2(s.y * LOG2E) * h[1] + e.y; h[2] = ex2(s.z * LOG2E) * h[2] + e.z; h[3] = ex2(s.w * LOG2E) * h[3] + e.w; }
#pragma unroll 16
        for (int r = 0; r < CHUNK; ++r) { const u32x2 lw = *(const u32x2*)(LA + (m0 + r) * RW + c), iw = *(const u32x2*)(INP + (m0 + r) * RW + c), gw = *(const u32x2*)(G + (m0 + r) * RW + c);
            const float l[4] = {bf_lo(lw.x), bf_hi(lw.x), bf_lo(lw.y), bf_hi(lw.y)}, in[4] = {bf_lo(iw.x), bf_hi(iw.x), bf_lo(iw.y), bf_hi(iw.y)}, gg[4] = {bf_lo(gw.x), bf_hi(gw.x), bf_lo(gw.y), bf_hi(gw.y)};
            float y[4];
#pragma unroll
            for (int j = 0; j < 4; ++j) { h[j] = ex2(l[j] * LOG2E) * h[j] + in[j]; y[j] = h[j] * gg[j]; }
            u32x2 o; o.x = cvt_pk_bf16(y[0], y[1]); o.y = cvt_pk_bf16(y[2], y[3]); *(u32x2*)(Y + (m0 + r) * RW + c) = o; }
    }
}
template <int NJ> __device__ __forceinline__ void colmax_matrix_t(const float* W, int K, int N, unsigned* cmax, int gw, int ngw, int lane, int ldw, int& off) {
    const int ncb = N / (256 * NJ), nitems = (K / 64) * ncb;
    const int first = (gw - off % ngw + ngw) % ngw; off += nitems;
    for (int it = first; it < nitems; it += ngw) { const int kb = it / ncb, nb = it % ncb; const GAS f32x4* p = (const GAS f32x4*)(W + (size_t)kb * 64 * ldw + nb * 256 * NJ) + lane;
        f32x4 mx[NJ];
#pragma unroll
        for (int j = 0; j < NJ; ++j) mx[j] = (f32x4){0.f, 0.f, 0.f, 0.f};
#pragma unroll 8
        for (int r = 0; r < 64; ++r) {
#pragma unroll
            for (int j = 0; j < NJ; ++j) { const f32x4 v = p[(size_t)r * (ldw / 4) + 64 * j]; mx[j].x = fmaxf(mx[j].x, fabsf(v.x)); mx[j].y = fmaxf(mx[j].y, fabsf(v.y)); mx[j].z = fmaxf(mx[j].z, fabsf(v.z)); mx[j].w = fmaxf(mx[j].w, fabsf(v.w)); } }
#pragma unroll
        for (int j = 0; j < NJ; ++j) { unsigned* c = cmax + nb * 256 * NJ + 256 * j + lane * 4;
            atomicMax(c, __float_as_uint(mx[j].x)); atomicMax(c + 1, __float_as_uint(mx[j].y)); atomicMax(c + 2, __float_as_uint(mx[j].z)); atomicMax(c + 3, __float_as_uint(mx[j].w)); } }
}
__device__ __forceinline__ void colmax_matrix(const float* W, int K, int N, unsigned* cmax, int gw, int ngw, int lane, int& off, int ldw = 0) {
    if (ldw == 0) ldw = N;
    if (N % 1024 == 0) colmax_matrix_t<4>(W, K, N, cmax, gw, ngw, lane, ldw, off); else colmax_matrix_t<2>(W, K, N, cmax, gw, ngw, lane, ldw, off);
}
__device__ __forceinline__ void quant_transpose_matrix(const float* W, int K, int N, signed char* WQ, const unsigned* cmax, float* wscale, LAS float* scr, const Deal d, int lane, int* csum = nullptr, int ldw = 0) {
    const int nblk = N / 32, nitems = (K / 64) * nblk; if (ldw == 0) ldw = N;
    int item = (d.wi * d.ngrp + d.g) * QCH; if (item >= nitems) return;
    float tv[32], tn[32]; TILE_LOAD(tv, item);
    unsigned tk = deal_issue(d, lane);
    for (;;) {
        int nxt = item + 1;
        if (nxt % QCH == 0) { nxt = (((int)__builtin_amdgcn_readfirstlane(tk) + d.nw) * d.ngrp + d.g) * QCH; if (nxt < nitems) tk = deal_issue(d, lane); }
        const int kb = item / nblk, nb = item % nblk, k0 = 64 * kb, n0 = 32 * nb; const bool more = nxt < nitems;
        if (more) TILE_LOAD(tn, nxt);
#pragma unroll
        for (int i = 0; i < 32; ++i) scr[(2 * i + (lane >> 5)) * 33 + (lane & 31)] = tv[i];
        LDS_WAIT(); asm volatile("" ::: "memory");
        const int c = lane & 7;
#pragma unroll
        for (int j = 0; j < 4; ++j) { const int n = (lane >> 3) + 8 * j; const LAS float* sp = scr + (8 * c) * 33 + n;
            const float cm = __uint_as_float(cmax[n0 + n]); const float inv = cm > 0.f ? 127.f / cm : 0.f;
            int q[8]; int qs = 0;
#pragma unroll
            for (int e = 0; e < 8; ++e) { float v = rintf(sp[e * 33] * inv); v = fminf(fmaxf(v, -127.f), 127.f); qs += (int)v; q[e] = (int)v & 0xff; }
            if (csum) { qs += __shfl_xor(qs, 1); qs += __shfl_xor(qs, 2); qs += __shfl_xor(qs, 4); if (c == 0) atomicAdd(csum + n0 + n, qs); }
            u32x2 o; o.x = (unsigned)(q[0] | (q[1] << 8) | (q[2] << 16) | (q[3] << 24)); o.y = (unsigned)(q[4] | (q[5] << 8) | (q[6] << 16) | (q[7] << 24));
            *(GAS u32x2*)(WQ + (size_t)(n0 + n) * K + k0 + 8 * c) = o;
            if (kb == 0 && c == 0) wscale[n0 + n] = cm * (1.f / 127.f); }
        LDS_WAIT(); asm volatile("" ::: "memory");
        if (!more) break;
#pragma unroll
        for (int i = 0; i < 32; ++i) tv[i] = tn[i];
        item = nxt;
    }
}
#define DYN_BEGIN(lds_, cnt_, nch_, CUR) { \
    volatile LAS unsigned* dsl_ = (volatile LAS unsigned*)((lds_) + LDS_DYN); const bool dt0_ = tid_() == 0; int ds_ = 0; const unsigned dg_ = (unsigned)gdim_(); \
    unsigned CUR = (unsigned)bx_(); \
    while (CUR < (unsigned)(nch_)) { unsigned dnx_ = 0u; if (dt0_) dnx_ = __hip_atomic_fetch_add((cnt_), 1u, __ATOMIC_RELAXED, __HIP_MEMORY_SCOPE_AGENT) + dg_;
#define DYN_END(CUR) \
        if (dt0_) dsl_[ds_] = dnx_; __syncthreads(); CUR = __builtin_amdgcn_readfirstlane(dsl_[ds_]); ds_ ^= 1; } }
#define DYN_CNT(ws_, id_) ((unsigned*)((ws_) + WS_CTL) + CW_DYN + 64 * (id_))
__device__ __forceinline__ void phase_quant_hidden(LAS unsigned char* lds, unsigned* cnt, const bf16* U, const unsigned* rowmax, signed char* UQ, float* ascale) {
    constexpr int TRIP = NTHREADS * 8, TPC = 2;
    constexpr unsigned NCH = (unsigned)((size_t)M * (FF / 8) / (TRIP * TPC));
    const int tid = tid_();
    DYN_BEGIN(lds, cnt, NCH, cur)
        for (int t = 0; t < TPC; ++t) {
            const size_t it0 = ((size_t)cur * TPC + t) * TRIP + tid;
            u32x4 w[8]; float am[8];
#pragma unroll
            for (int k = 0; k < 8; ++k) { const size_t it = it0 + k * NTHREADS; const int m = (int)(it / (FF / 8)), c8 = (int)(it % (FF / 8));
                w[k] = *(const GAS u32x4*)(U + (size_t)m * FF + c8 * 8); am[k] = __uint_as_float(rowmax[m]); }
#pragma unroll
            for (int k = 0; k < 8; ++k) { const size_t it = it0 + k * NTHREADS; const int m = (int)(it / (FF / 8)), c8 = (int)(it % (FF / 8));
                const float inv = am[k] > 0.f ? 255.f / am[k] : 0.f;
                const float a[8] = {bf_lo(w[k].x), bf_hi(w[k].x), bf_lo(w[k].y), bf_hi(w[k].y), bf_lo(w[k].z), bf_hi(w[k].z), bf_lo(w[k].w), bf_hi(w[k].w)};
                int q[8];
#pragma unroll
                for (int e = 0; e < 8; ++e) { float v = fminf(rintf(a[e] * inv), 255.f); q[e] = ((int)v - 128) & 0xff; }
                u32x2 o; o.x = (unsigned)(q[0] | (q[1] << 8) | (q[2] << 16) | (q[3] << 24)); o.y = (unsigned)(q[4] | (q[5] << 8) | (q[6] << 16) | (q[7] << 24));
                *(GAS u32x2*)(UQ + (size_t)m * FF + c8 * 8) = o;
                if (c8 == 0) ascale[m] = am[k] * (1.f / 255.f); }
        }
    DYN_END(cur)
}
template <int NJ> __device__ __forceinline__ void phase_quant_rows(const bf16* src, signed char* dst, float* scale) {
    const int tid = tid_(), lane = tid & 63, gw = bx_() * NWAVES + (tid >> 6), ngw = gdim_() * NWAVES; constexpr int NC = 256 * NJ;
    for (int m = gw; m < M; m += ngw) {
        const GAS u32x2* sr = (const GAS u32x2*)(src + (size_t)m * NC) + lane; u32x2 w[NJ]; float am = 0.f;
#pragma unroll
        for (int j = 0; j < NJ; ++j) w[j] = sr[64 * j];
#pragma unroll
        for (int j = 0; j < NJ; ++j) am = fmaxf(am, fmaxf(fmaxf(fabsf(bf_lo(w[j].x)), fabsf(bf_hi(w[j].x))), fmaxf(fabsf(bf_lo(w[j].y)), fabsf(bf_hi(w[j].y)))));
#pragma unroll
        for (int o = 1; o < 64; o <<= 1) am = fmaxf(am, __shfl_xor(am, o));
        const float inv = am > 0.f ? 127.f / am : 0.f; GAS unsigned* o4 = (GAS unsigned*)(dst + (size_t)m * NC) + lane;
#pragma unroll
        for (int j = 0; j < NJ; ++j) { const int a = (int)rintf(bf_lo(w[j].x) * inv) & 0xff, b = (int)rintf(bf_hi(w[j].x) * inv) & 0xff, c = (int)rintf(bf_lo(w[j].y) * inv) & 0xff, d = (int)rintf(bf_hi(w[j].y) * inv) & 0xff;
            o4[64 * j] = (unsigned)(a | (b << 8) | (c << 16) | (d << 24)); }
        if (lane == 0) scale[m] = am * (1.f / 127.f);
    }
}
__device__ __forceinline__ void phase_kmean(const bf16* K, bf16* KMH, bf16* KML) {
    const int nitems = BATCH * 16 * (D / 2);
    for (int it = bx_() * NTHREADS + tid_(); it < nitems; it += gdim_() * NTHREADS) {
        const int c2 = it % (D / 2), bj = it / (D / 2), b = bj / 16, j = bj % 16, c = c2 * 2;
        const bf16* p = K + ((size_t)b * SEQ + (size_t)j * 256) * D + c; float s0 = 0.f, s1 = 0.f;
#pragma unroll 32
        for (int r = 0; r < 256; ++r) { const unsigned w = *(const unsigned*)(p + (size_t)r * D); s0 += bf_lo(w); s1 += bf_hi(w); }
        s0 *= (1.f / 256.f); s1 *= (1.f / 256.f);
        const unsigned hw = cvt_pk_bf16(s0, s1); const unsigned lw = cvt_pk_bf16(s0 - bf_lo(hw), s1 - bf_hi(hw));
        const int h = c / HD, d = c % HD; const size_t o = (((size_t)b * NH + h) * 16 + j) * HD + d;
        *(unsigned*)(KMH + o) = hw; *(unsigned*)(KML + o) = lw;
    }
}
namespace att {
constexpr int SHM = 16384;
constexpr int OFF_V = 0, OFF_K = 2 * SHM, OFF_WS = 4 * SHM, OFF_TBL = OFF_WS + 2048, OFF_FLAG = OFF_TBL + 512, OFF_WM = OFF_FLAG + 64, OFF_KM = OFF_WM + 64;
constexpr float SCALE = 0.08838834764831845f;
constexpr float C2 = SCALE * 1.4426950408889634f;
#define KSWZ(row, colB) ((row) * 256 + ((colB) ^ (((row) & 7) << 4)))
__device__ __forceinline__ int v_st(int k, int c) { const int kk = (k & ~0xC) | ((k & 4) << 1) | ((k & 8) >> 1); return ((kk >> 3) * 4 + (c >> 5)) * 512 + ((kk & 7) * 32 + (c & 31)) * 2; }
__device__ __forceinline__ int v_rd_base(int lane) { return ((lane & 3) << 3) | (((lane >> 2) & 3) << 6) | (((lane >> 4) & 1) << 5) | (((lane >> 5) & 1) << 8); }
__device__ __forceinline__ int crow(int r, int hi) { return (r & 3) + 8 * (r >> 2) + 4 * hi; }
#define SBAR() __builtin_amdgcn_sched_barrier(0)

__device__ __forceinline__ void qkt(f32x16& p0, f32x16& p1, LAS const char* Kt, int r32, int hi, const bf16x8* qr) {
    p0 = f32x16{}; p1 = f32x16{};
    LAS const char* kb[4];
#pragma unroll
    for (int dd = 0; dd < 4; ++dd) kb[dd] = Kt + KSWZ(r32, (dd * 16 + hi * 8) * 2);
#pragma unroll
    for (int d0 = 0; d0 < 8; ++d0) { LAS const char* a = kb[d0 & 3] + (d0 >> 2) * 128;
        const bf16x8 b0 = *(LAS const bf16x8*)a, b1 = *(LAS const bf16x8*)(a + 32 * 256);
        p0 = __builtin_amdgcn_mfma_f32_32x32x16_bf16(b0, qr[d0], p0, 0, 0, 0);
        p1 = __builtin_amdgcn_mfma_f32_32x32x16_bf16(b1, qr[d0], p1, 0, 0, 0); }
}
__device__ __forceinline__ void qk32(f32x16& p0, LAS const char* Kt, int r32, int hi, const bf16x8* qr) {
    p0 = f32x16{};
    LAS const char* kb[4];
#pragma unroll
    for (int dd = 0; dd < 4; ++dd) kb[dd] = Kt + KSWZ(r32, (dd * 16 + hi * 8) * 2);
#pragma unroll
    for (int d0 = 0; d0 < 8; ++d0) { const bf16x8 b0 = *(LAS const bf16x8*)(kb[d0 & 3] + (d0 >> 2) * 128); p0 = __builtin_amdgcn_mfma_f32_32x32x16_bf16(b0, qr[d0], p0, 0, 0, 0); }
}
__device__ __forceinline__ void pv_tile(f32x16* o, int vb, bf16x8 pa0, bf16x8 pa1, bf16x8 pa2, bf16x8 pa3) {
#define TRRD(dst, off) asm volatile("ds_read_b64_tr_b16 %0, %1 offset:%2" : "=&v"(dst) : "v"(vb), "i"(off) : "memory")
#define PV_D0(d0) do { s16x4 l0, l1, l2, l3, h0, h1, h2, h3; constexpr int b_ = (d0) * 512; \
        TRRD(l0, b_); TRRD(h0, b_ + 2048); TRRD(l1, b_ + 4096); TRRD(h1, b_ + 6144); TRRD(l2, b_ + 8192); TRRD(h2, b_ + 10240); TRRD(l3, b_ + 12288); TRRD(h3, b_ + 14336); \
        asm volatile("s_waitcnt lgkmcnt(0)" ::: "memory"); SBAR(); \
        o[d0] = __builtin_amdgcn_mfma_f32_32x32x16_bf16(pa0, (bf16x8){l0[0], l0[1], l0[2], l0[3], h0[0], h0[1], h0[2], h0[3]}, o[d0], 0, 0, 0); \
        o[d0] = __builtin_amdgcn_mfma_f32_32x32x16_bf16(pa1, (bf16x8){l1[0], l1[1], l1[2], l1[3], h1[0], h1[1], h1[2], h1[3]}, o[d0], 0, 0, 0); \
        o[d0] = __builtin_amdgcn_mfma_f32_32x32x16_bf16(pa2, (bf16x8){l2[0], l2[1], l2[2], l2[3], h2[0], h2[1], h2[2], h2[3]}, o[d0], 0, 0, 0); \
        o[d0] = __builtin_amdgcn_mfma_f32_32x32x16_bf16(pa3, (bf16x8){l3[0], l3[1], l3[2], l3[3], h3[0], h3[1], h3[2], h3[3]}, o[d0], 0, 0, 0); } while (0)
    PV_D0(0); PV_D0(1); PV_D0(2); PV_D0(3);
#undef PV_D0
#undef TRRD
}
__device__ __forceinline__ void pack_p(const f32x16& p0, const f32x16& p1, bf16x8& pa0, bf16x8& pa1, bf16x8& pa2, bf16x8& pa3) {
#define PK4(P, B_, OUT) do { unsigned a0 = cvt_pk_bf16(P[B_+0], P[B_+1]), a1 = cvt_pk_bf16(P[B_+2], P[B_+3]); \
        unsigned b0 = cvt_pk_bf16(P[B_+4], P[B_+5]), b1 = cvt_pk_bf16(P[B_+6], P[B_+7]); \
        auto r0 = __builtin_amdgcn_permlane32_swap(a0, b0, false, false); auto r1 = __builtin_amdgcn_permlane32_swap(a1, b1, false, false); \
        u32x4 w = {r0[0], r1[0], r0[1], r1[1]}; OUT = *reinterpret_cast<bf16x8*>(&w); } while (0)
    PK4(p0, 0, pa0); PK4(p0, 8, pa1); PK4(p1, 0, pa2); PK4(p1, 8, pa3);
#undef PK4
}
__device__ __forceinline__ void both_halves(float v, float& lo, float& hi_) {
    auto rr = __builtin_amdgcn_permlane32_swap(__float_as_uint(v), __float_as_uint(v), false, false); lo = __uint_as_float(rr[0]); hi_ = __uint_as_float(rr[1]);
}
struct Stage { bf16x8 k0, k1, v0, v1; };
__device__ __forceinline__ void stage_load(Stage& s, const bf16* Kp, const bf16* Vp, size_t row0, int sr, int colsc) {
    s.k0 = *(const bf16x8*)(Kp + (row0 + sr) * D + colsc); s.k1 = *(const bf16x8*)(Kp + (row0 + 32 + sr) * D + colsc);
    s.v0 = *(const bf16x8*)(Vp + (row0 + sr) * D + colsc); s.v1 = *(const bf16x8*)(Vp + (row0 + 32 + sr) * D + colsc);
}
__device__ __forceinline__ void stage_write(const Stage& s, LAS char* lds, int buf, int kws, int vst0, int vst1) {
    *(LAS bf16x8*)(lds + OFF_K + buf * SHM + kws) = s.k0; *(LAS bf16x8*)(lds + OFF_K + buf * SHM + kws + 32 * 256) = s.k1;
    *(LAS bf16x8*)(lds + OFF_V + buf * SHM + vst0) = s.v0; *(LAS bf16x8*)(lds + OFF_V + buf * SHM + vst1) = s.v1;
}
__device__ __forceinline__ void store_o(const f32x16* o, const float* rs, bf16* Ow, int r32, int hi) {
#pragma unroll
    for (int r = 0; r < 16; ++r) { const int orow = crow(r, hi);
#pragma unroll
        for (int d0 = 0; d0 < 4; ++d0) { const float v = o[d0][r] * rs[r]; const float vn = __shfl_xor(v, 1);
            if ((r32 & 1) == 0) *(unsigned*)(Ow + (size_t)orow * D + d0 * 32 + r32) = cvt_pk_bf16(v, vn); } }
}

__device__ __forceinline__ void sb_unit(LAS char* lds, const bf16* Q, const bf16* K, const bf16* V, bf16* O, int b, int h, int qb, unsigned& token) {
    const int tid = tid_(), wid = __builtin_amdgcn_readfirstlane(tid >> 6), lane = tid & 63, r32 = lane & 31, hi = lane >> 5;
    const size_t rowbase = (size_t)b * SEQ; const int q0 = qb * 256, qlo = q0 + wid * 32, t = qlo + r32;
    const int sr = tid >> 4, sc = (tid & 15) * 8, colsc = h * HD + sc, kws = KSWZ(sr, sc * 2), vst0 = v_st(sr, sc), vst1 = v_st(32 + sr, sc);
    volatile LAS unsigned* flag = (volatile LAS unsigned*)(lds + OFF_FLAG);
    bf16x8 qr[8];
#pragma unroll
    for (int d0 = 0; d0 < 8; ++d0) qr[d0] = *(const bf16x8*)(Q + (rowbase + qlo + r32) * D + h * HD + d0 * 16 + hi * 8);
    f32x16 o[4] = {}; float carry = 0.f;
    const int ntiles = q0 / 64 + 4;
    Stage st; stage_load(st, K, V, rowbase + (size_t)(ntiles - 1) * 64, sr, colsc); VM_WAIT(); stage_write(st, lds, 0, kws, vst0, vst1);
    __syncthreads();
    const int vbase = (int)(uintptr_t)(lds + OFF_V) + v_rd_base(lane);
    for (int it = 0; it < ntiles; ++it) {
        const int tile = ntiles - 1 - it, kb = tile * 64, buf = it & 1;
        if (it + 1 < ntiles) stage_load(st, K, V, rowbase + (size_t)(tile - 1) * 64, sr, colsc);
        const bool alive = __any(carry > -150.f);
        if (kb <= qlo + 30 && alive) {
            f32x16 p0, p1; qkt(p0, p1, lds + OFF_K + buf * SHM, r32, hi, qr);
            const int dq = t - kb - 4 * hi;
            float lk0[16], lk1[16];
#pragma unroll
            for (int r = 0; r < 16; ++r) { const int c = (r & 3) + 8 * (r >> 2);
                { const float z = p0[r] * C2, l = lg2(1.f + ex2(-fabsf(z))); const bool ok = c < dq; lk0[r] = ok ? fminf(-z, 0.f) - l : 0.f; p0[r] = ok ? fminf(z, 0.f) - l : -__builtin_inff(); }
                { const float z = p1[r] * C2, l = lg2(1.f + ex2(-fabsf(z))); const bool ok = c + 32 < dq; lk1[r] = ok ? fminf(-z, 0.f) - l : 0.f; p1[r] = ok ? fminf(z, 0.f) - l : -__builtin_inff(); } }
            float ge[8], go[8];
#pragma unroll
            for (int k = 0; k < 4; ++k) { const float g0 = (lk0[4 * k] + lk0[4 * k + 1]) + (lk0[4 * k + 2] + lk0[4 * k + 3]), g1 = (lk1[4 * k] + lk1[4 * k + 1]) + (lk1[4 * k + 2] + lk1[4 * k + 3]);
                both_halves(g0, ge[k], go[k]); both_halves(g1, ge[4 + k], go[4 + k]); }
            float suf[8]; float s = carry;
#pragma unroll
            for (int k = 7; k >= 0; --k) { const float so = s; s += go[k]; const float se = s; s += ge[k]; suf[k] = hi ? so : se; }
            carry = s;
#pragma unroll
            for (int k = 0; k < 4; ++k) {
                { float a = suf[k]; p0[4 * k + 3] = ex2(p0[4 * k + 3] + a); a += lk0[4 * k + 3]; p0[4 * k + 2] = ex2(p0[4 * k + 2] + a); a += lk0[4 * k + 2]; p0[4 * k + 1] = ex2(p0[4 * k + 1] + a); a += lk0[4 * k + 1]; p0[4 * k] = ex2(p0[4 * k] + a); }
                { float a = suf[4 + k]; p1[4 * k + 3] = ex2(p1[4 * k + 3] + a); a += lk1[4 * k + 3]; p1[4 * k + 2] = ex2(p1[4 * k + 2] + a); a += lk1[4 * k + 2]; p1[4 * k + 1] = ex2(p1[4 * k + 1] + a); a += lk1[4 * k + 1]; p1[4 * k] = ex2(p1[4 * k] + a); } }
            bf16x8 pa0, pa1, pa2, pa3; pack_p(p0, p1, pa0, pa1, pa2, pa3);
            pv_tile(o, vbase + buf * SHM, pa0, pa1, pa2, pa3);
        }
        if (it + 1 < ntiles) { VM_WAIT(); stage_write(st, lds, buf ^ 1, kws, vst0, vst1); }
        ++token;
        if (__any(carry > -150.f) && lane == 0) flag[it & 1] = token;
        __syncthreads();
        if (flag[it & 1] != token) break;
    }
    float ones[16];
#pragma unroll
    for (int r = 0; r < 16; ++r) ones[r] = 1.f;
    store_o(o, ones, O + (rowbase + qlo) * D + h * HD, r32, hi);
    __syncthreads();
}

constexpr int MV = 0, MK = 3 * SHM, MWS = 5 * SHM, MTBL = MWS + 2048, MWM = MTBL + 512, MKM = MWM + 64;
__device__ __forceinline__ void stage_write_at(const Stage& s, LAS char* lds, int koff, int voff, int kws, int vst0, int vst1) {
    *(LAS bf16x8*)(lds + koff + kws) = s.k0; *(LAS bf16x8*)(lds + koff + kws + 32 * 256) = s.k1;
    *(LAS bf16x8*)(lds + voff + vst0) = s.v0; *(LAS bf16x8*)(lds + voff + vst1) = s.v1;
}
__device__ __forceinline__ void moba_unit(LAS char* lds, const bf16* Q, const bf16* K, const bf16* V, bf16* O, const bf16* KMH, const bf16* KML, const float* relb, int b, int h, int qb) {
    const int tid = tid_(), wid = __builtin_amdgcn_readfirstlane(tid >> 6), lane = tid & 63, r32 = lane & 31, hi = lane >> 5;
    const size_t rowbase = (size_t)b * SEQ; const int q0 = qb * 256, qlo = q0 + wid * 32, t = qlo + r32;
    const int sr = tid >> 4, sc = (tid & 15) * 8, colsc = h * HD + sc, kws = KSWZ(sr, sc * 2), vst0 = v_st(sr, sc), vst1 = v_st(32 + sr, sc);
    LAS float* tbl = (LAS float*)(lds + MTBL); LAS float* wsf = (LAS float*)(lds + MWS) + wid * 64; LAS float* li_l = wsf; LAS float* al_l = wsf + 32;
    volatile LAS unsigned* wm = (volatile LAS unsigned*)(lds + MWM);
    bf16x8 qr[8];
#pragma unroll
    for (int d0 = 0; d0 < 8; ++d0) qr[d0] = *(const bf16x8*)(Q + (rowbase + qlo + r32) * D + h * HD + d0 * 16 + hi * 8);
    if (tid < 128) { const int d = tid; int bk = d; if (d >= 16) { bk = 16 + (int)(lg2((float)d * (1.f / 16.f)) * (16.f / 3.f)); bk = bk > 31 ? 31 : bk; } tbl[d] = relb[bk * NH + h] * LOG2E; }
    if (tid < 256) { const int row = tid >> 4, ch = tid & 15; *(LAS bf16x8*)(lds + MKM + KSWZ(row, ch * 16)) = *(const bf16x8*)(KMH + (((size_t)b * NH + h) * 16 + row) * HD + ch * 8); }
    else { const int row = (tid - 256) >> 4, ch = tid & 15; *(LAS bf16x8*)(lds + MKM + 8192 + KSWZ(row, ch * 16)) = *(const bf16x8*)(KML + (((size_t)b * NH + h) * 16 + row) * HD + ch * 8); }
    __syncthreads();
    unsigned selmask = 0u;
    if (qb > 0) {
        f32x16 gh, gl; qk32(gh, lds + MKM, r32, hi, qr); qk32(gl, lds + MKM + 8192, r32, hi, qr);
        float g[16];
#pragma unroll
        for (int r = 0; r < 8; ++r) { float a, c; both_halves(gh[r] + gl[r], a, c); const int j0 = (r & 3) + 8 * (r >> 2); g[j0] = a; g[j0 + 4] = c; }
        unsigned key[16];
#pragma unroll
        for (int i = 0; i < 16; ++i) { unsigned sb = __float_as_uint(g[i]); sb = (sb & 0x80000000u) ? ~sb : (sb | 0x80000000u); key[i] = (i < qb) ? ((sb & ~15u) | (unsigned)(15 - i)) : 0u; }
        unsigned m1 = 0u, m2 = 0u, m3 = 0u;
#pragma unroll
        for (int i = 0; i < 16; ++i) m1 = key[i] > m1 ? key[i] : m1;
#pragma unroll
        for (int i = 0; i < 16; ++i) { const unsigned kx = key[i] < m1 ? key[i] : 0u; m2 = kx > m2 ? kx : m2; }
#pragma unroll
        for (int i = 0; i < 16; ++i) { const unsigned kx = key[i] < m2 ? key[i] : 0u; m3 = kx > m3 ? kx : m3; }
#pragma unroll
        for (int j = 0; j < 16; ++j) selmask |= (key[j] != 0u && key[j] >= m3) ? (1u << j) : 0u;
    }
    unsigned wmask = 0u;
#pragma unroll
    for (int j = 0; j < 16; ++j) wmask |= (__any((selmask >> j) & 1u) ? 1u : 0u) << j;
    wmask |= 1u << qb;
    if (lane == 0) wm[wid] = wmask;
    __syncthreads();
    unsigned gmask = 0u;
#pragma unroll
    for (int w = 0; w < 8; ++w) gmask |= wm[w];
    gmask = __builtin_amdgcn_readfirstlane(gmask);
    const int nblk = __builtin_popcount(gmask), ntiles = nblk * 4;
    float m_reg = -1e30f, l_reg = 0.f; f32x16 o[4] = {};
    const float far2 = tbl[127];
    const int vbase = (int)(uintptr_t)(lds + MV) + v_rd_base(lane);
    const bool late = wid >= 4; bool pend = false; int pend_vb = 0; bf16x8 pa0 = {}, pa1 = {}, pa2 = {}, pa3 = {};
    unsigned rem = gmask; int jcur = __builtin_ctz(rem); rem &= rem - 1;
    Stage st; stage_load(st, K, V, rowbase + (size_t)jcur * 256, sr, colsc); VM_WAIT(); stage_write_at(st, lds, MK, MV, kws, vst0, vst1);
    __syncthreads();
    int sub = 0;
    for (int it = 0; it < ntiles; ++it) {
        const int buf = it & 1, j = jcur, kb = j * 256 + sub * 64;
        int jn = j, subn = sub + 1; if (subn == 4) { subn = 0; if (rem) { jn = __builtin_ctz(rem); rem &= rem - 1; } }
        if (it + 1 < ntiles) stage_load(st, K, V, rowbase + (size_t)jn * 256 + subn * 64, sr, colsc);
        const bool act = (j == qb) ? (kb <= qlo + 31) : (((wmask >> j) & 1u) != 0u);
        if (pend) { pv_tile(o, vbase + pend_vb * SHM, pa0, pa1, pa2, pa3); pend = false; }
        if (act) {
            f32x16 p0, p1; qkt(p0, p1, lds + MK + buf * SHM, r32, hi, qr);
            const bool rowsel = (j == qb) || (((selmask >> j) & 1u) != 0u);
            const float NEG = -__builtin_inff();
            const bool near = (j + 1 >= qb);
            if (near) {
                const int dq = t - kb - 4 * hi;
#pragma unroll
                for (int r = 0; r < 16; ++r) { const int c = (r & 3) + 8 * (r >> 2); const int d0 = dq - c, d1 = dq - c - 32;
                    const float b0 = tbl[d0 < 0 ? 0 : (d0 > 127 ? 127 : d0)], b1 = tbl[d1 < 0 ? 0 : (d1 > 127 ? 127 : d1)];
                    p0[r] = (rowsel && d0 >= 0) ? fmaf(p0[r], C2, b0) : NEG; p1[r] = (rowsel && d1 >= 0) ? fmaf(p1[r], C2, b1) : NEG; }
            }
            float pmax = p0[0];
#pragma unroll
            for (int r = 1; r < 16; ++r) pmax = fmaxf(pmax, p0[r]);
#pragma unroll
            for (int r = 0; r < 16; ++r) pmax = fmaxf(pmax, p1[r]);
            { float a, c; both_halves(pmax, a, c); pmax = fmaxf(a, c); }
            float off;
            if (!near) { const float brow = rowsel ? far2 : NEG; pmax = fmaf(pmax, C2, brow); }
            float alpha = 1.f;
            if (!__all(pmax - m_reg <= 11.f)) { const float mn = fmaxf(m_reg, pmax); alpha = ex2(m_reg - mn); m_reg = mn; }
            if (!near) { off = (rowsel ? far2 : NEG) - m_reg;
#pragma unroll
                for (int r = 0; r < 16; ++r) { p0[r] = ex2(fmaf(p0[r], C2, off)); p1[r] = ex2(fmaf(p1[r], C2, off)); } }
            else {
#pragma unroll
                for (int r = 0; r < 16; ++r) { p0[r] = ex2(p0[r] - m_reg); p1[r] = ex2(p1[r] - m_reg); } }
            float ps = 0.f;
#pragma unroll
            for (int r = 0; r < 16; ++r) ps += p0[r] + p1[r];
            { float a, c; both_halves(ps, a, c); ps = a + c; }
            l_reg = l_reg * alpha + ps;
            if (__any(alpha < 1.f)) { if (hi == 0) al_l[r32] = alpha; LDS_WAIT();
#pragma unroll
                for (int d_ = 0; d_ < 4; ++d_)
#pragma unroll
                    for (int r = 0; r < 16; ++r) o[d_][r] *= al_l[crow(r, hi)]; }
            pack_p(p0, p1, pa0, pa1, pa2, pa3);
            if (late) { pend = true; pend_vb = it % 3; } else pv_tile(o, vbase + (it % 3) * SHM, pa0, pa1, pa2, pa3);
        }
        if (it + 1 < ntiles) { VM_WAIT(); stage_write_at(st, lds, MK + (buf ^ 1) * SHM, MV + ((it + 1) % 3) * SHM, kws, vst0, vst1); }
        jcur = jn; sub = subn;
        __syncthreads();
    }
    if (pend) pv_tile(o, vbase + pend_vb * SHM, pa0, pa1, pa2, pa3);
    if (hi == 0) li_l[r32] = l_reg; LDS_WAIT();
    float rli[16];
#pragma unroll
    for (int r = 0; r < 16; ++r) rli[r] = rcpf_(li_l[crow(r, hi)]);
    store_o(o, rli, O + (rowbase + qlo) * D + h * HD, r32, hi);
    __syncthreads();
}
#undef KSWZ
#undef SBAR
}
#ifndef WGM_UP
#define WGM_UP 4
#endif
#ifndef WGM_DN
#define WGM_DN 4
#endif
#ifndef WGM_X
#define WGM_X 4
#endif
#ifndef REP_GEMM
#define REP_GEMM 1
#endif
#ifndef REP_THIN
#define REP_THIN 1
#endif
#ifndef REP_PRO
#define REP_PRO 1
#endif
#ifndef REP_RES
#define REP_RES 1
#endif
#ifndef REP_BAR
#define REP_BAR 1
#endif
#ifndef REP_ATT
#define REP_ATT 1
#endif
struct Args { const float* in[23]; float* out; unsigned char* ws; int ph_lo, ph_hi; };
constexpr int NPHASES = 37;

__global__ void __launch_bounds__(NTHREADS, 2) trunk_fwd(Args args) {
    extern __shared__ __attribute__((aligned(16))) unsigned char lds_raw[];
    LAS unsigned char* lds = (LAS unsigned char*)lds_raw;
    const int G = gridDim.x, bx = blockIdx.x;
    unsigned char* ws = args.ws;
    for (int u = tid_(); u < (LDS_BYTES - LDSCTL_OFF) / 4; u += NTHREADS) ((LAS unsigned*)(lds + LDSCTL_OFF))[u] = 0u;
    __syncthreads();
    const int lo = args.ph_lo, hi = args.ph_hi;
    XcdBarrier bar; bar.bar = (unsigned*)(ws + WS_CTL) + CW_BAR; bar.x = 0; bar.st = nullptr;
    if (hi - lo > 1) bar = xcd_barrier_post((unsigned*)(ws + WS_CTL) + CW_BAR, (volatile LAS unsigned*)(lds + LDSCTL_OFF + 64));
#define INR(k) (lo <= (k) && (k) < hi)
#define IN(k) INR((k) + ((k) >= 1 ? 1 : 0))
#define SEAMR(k) do { if (INR(k) && INR((k) + 1)) xcd_barrier(bar); } while (0)
#define SEAM(k) do { if (IN(k) && IN((k) + 1)) for (int rb_ = 0; rb_ < REP_BAR; ++rb_) xcd_barrier(bar); } while (0)

    const float* x_in = args.in[0]; bf16* xo = (bf16*)(ws + WS_X16);
    bf16* HB = (bf16*)(ws + WS_HB); bf16* MX = (bf16*)(ws + WS_MX); unsigned char* scr = ws + WS_SCR;
    bf16* U = (bf16*)(scr + SCR_U);

    if (IN(0)) for (int rep_ = 0; rep_ < REP_PRO; ++rep_) {
        const int tid = tid_(), lane = tid & 63, wave = __builtin_amdgcn_readfirstlane(tid >> 6), gw = bx * NWAVES + wave, ngw = G * NWAVES;
        LAS float* tscr = (LAS float*)(lds + wave * 16384); int cmoff = 0;
        const int gwp = wave * G + bx;
        for (int j = 0; j < 2; ++j) {
            colmax_matrix(args.in[5] + (size_t)j * D * 2 * RW, D, 2 * RW, (unsigned*)(ws + WS_CTL) + CW_COLMAX_LIN + j * 2 * RW, gwp, ngw, lane, cmoff);
            transpose_matrix(args.in[14] + (size_t)j * RW * D, RW, D, (bf16*)(ws + WS_WLOUT) + (size_t)j * D * RW, tscr, deal_make((unsigned*)(ws + WS_CTL), 2 + j, bx, G, wave), lane);
            gate_weights(args.in[9] + (size_t)j * NBLK * BW * BW, args.in[11] + (size_t)j * NBLK * BW * BW, (bf16*)(ws + WS_WGATE) + (size_t)j * NGATE * BWP);
        }
        colmax_matrix(args.in[16], D, 3 * D, (unsigned*)(ws + WS_CTL) + CW_COLMAX_SQKV, gwp, ngw, lane, cmoff);
        colmax_matrix(args.in[17], D, D, (unsigned*)(ws + WS_CTL) + CW_COLMAX_WO, gwp, ngw, lane, cmoff);
        colmax_matrix(args.in[18], D, 3 * D, (unsigned*)(ws + WS_CTL) + CW_COLMAX_MKV, gwp, ngw, lane, cmoff);
        colmax_matrix(args.in[19], D, D, (unsigned*)(ws + WS_CTL) + CW_COLMAX_WO + D, gwp, ngw, lane, cmoff);
        for (int l = 0; l < DEPTH; ++l) {
            colmax_matrix(args.in[21] + (size_t)l * D * FF, D, FF, (unsigned*)(ws + WS_CTL) + CW_COLMAX + l * FF, gwp, ngw, lane, cmoff);
            colmax_matrix(args.in[22] + (size_t)l * FF * D, FF, D, (unsigned*)(ws + WS_CTL) + CW_COLMAX_DN + l * D, gwp, ngw, lane, cmoff);
        }
        for (int i = bx * NTHREADS + tid; i < 2 * RW; i += G * NTHREADS) { const float lam = args.in[13][i]; ((float*)(ws + WS_SP8))[i] = 8.f * log1pf(expf(-lam)); }
        { const Deal d = deal_make((unsigned*)(ws + WS_CTL), 4, bx, G, wave);
          int m = d.wi * d.ngrp + d.g;
          while (m < M) { const unsigned tk = deal_issue(d, lane);
              norm_row_q(x_in + (size_t)m * D, args.in[1], (signed char*)HB + (size_t)m * D, (float*)(ws + WS_HSCALE) + m, lane);
              m = ((int)__builtin_amdgcn_readfirstlane(tk) + d.nw) * d.ngrp + d.g; } }
    }
    SEAMR(0);
    if (INR(1)) {
        const int tid = tid_(), lane = tid & 63, wave = __builtin_amdgcn_readfirstlane(tid >> 6), gw = bx * NWAVES + wave, ngw = G * NWAVES;
        LAS float* tscr = (LAS float*)(lds + wave * 16384); unsigned* ctl_ = (unsigned*)(ws + WS_CTL);
#define DEAL(site) deal_make(ctl_, site, bx, G, wave)
        quant_transpose_matrix(args.in[17], D, D, (signed char*)(ws + WS_WSO), (const unsigned*)(ws + WS_CTL) + CW_COLMAX_WO, (float*)(ws + WS_WSCALE_WO), tscr, DEAL(20), lane);
        quant_transpose_matrix(args.in[19], D, D, (signed char*)(ws + WS_WMO), (const unsigned*)(ws + WS_CTL) + CW_COLMAX_WO + D, (float*)(ws + WS_WSCALE_WO) + D, tscr, DEAL(21), lane);
        quant_transpose_matrix(args.in[18], D, 3 * D, (signed char*)(ws + WS_WMQKV), (const unsigned*)(ws + WS_CTL) + CW_COLMAX_MKV, (float*)(ws + WS_WSCALE_MKV), tscr, DEAL(22), lane);
        quant_transpose_matrix(args.in[16], D, 3 * D, (signed char*)(ws + WS_WSQKV), (const unsigned*)(ws + WS_CTL) + CW_COLMAX_SQKV, (float*)(ws + WS_WSCALE_SQKV), tscr, DEAL(23), lane);
        for (int j = 0; j < 2; ++j) quant_transpose_matrix(args.in[5] + (size_t)j * D * 2 * RW, D, 2 * RW, (signed char*)(ws + WS_WLIN) + (size_t)j * 2 * RW * D * 2, (const unsigned*)(ws + WS_CTL) + CW_COLMAX_LIN + j * 2 * RW, (float*)(ws + WS_WSCALE_LIN) + j * 2 * RW, tscr, DEAL(24 + j), lane);
        for (int l = 0; l < DEPTH; ++l) quant_transpose_matrix(args.in[22] + (size_t)l * FF * D, FF, D, (signed char*)(ws + WS_WDN) + (size_t)l * D * FF, (const unsigned*)(ws + WS_CTL) + CW_COLMAX_DN + l * D, (float*)(ws + WS_WSCALE_DN) + l * D, tscr, DEAL(26 + l), lane, (int*)(ws + WS_CTL) + CW_CS_DN + l * D);
        for (int l = 0; l < DEPTH; ++l) quant_transpose_matrix(args.in[21] + (size_t)l * D * FF, D, FF, (signed char*)(ws + WS_WUP) + (size_t)l * FF * D, (const unsigned*)(ws + WS_CTL) + CW_COLMAX + l * FF, (float*)(ws + WS_WSCALE) + l * FF, tscr, DEAL(30 + l), lane);
    }
    SEAMR(1);

#define RES_PHASE(XIN_, MX_, GP_, XO_, GN_, HB_) phase_res<1, false, false>(lds, XIN_, MX_, GP_, XO_, GN_, HB_, nullptr, nullptr)
#define RES_PHASE_Q(XIN_, MX_, GP_, XO_, GN_) phase_res<2, false, false>(lds, XIN_, MX_, GP_, XO_, GN_, nullptr, (signed char*)HB, (float*)(ws + WS_HSCALE))
#define GEMM_PHASE(EPI_T, Aptr, Btptr, N_, K_, lda_, ldb_, E_, grp_, akstep_) do { \
        pg8::Gemm g_{(const bf16*)(Aptr), (const bf16*)(Btptr), M, (N_), (K_), (lda_), (ldb_)}; pg8::StaticOrder S_; S_.init(M, (N_), G, bx, (grp_), (akstep_), WGM_X); \
        for (int rep_ = 0; rep_ < REP_GEMM; ++rep_) pg8::gemm_phase<EPI_T, pg8::StaticOrder, true>(lds, g_, S_, E_); } while (0)

#define GEMM_PHASE_I8W(EPI_T, Aptr, Btptr, N_, K2_, E_, W_) do { \
        pg8::Gemm g_{(const bf16*)(Aptr), (const bf16*)(Btptr), M, (N_), (K2_), (K2_), (K2_)}; pg8::StaticOrder S_; S_.init(M, (N_), G, bx, 0, 0, (W_)); \
        for (int rep_ = 0; rep_ < REP_GEMM; ++rep_) pg8::gemm_phase<EPI_T, pg8::StaticOrder, true, true>(lds, g_, S_, E_); } while (0)
#define GEMM_PHASE_I8(EPI_T, Aptr, Btptr, N_, K2_, E_) GEMM_PHASE_I8W(EPI_T, Aptr, Btptr, N_, K2_, E_, WGM_X)
#define UP_PHASE(L) do { pg8::EpiBf16<1> E_{U, FF, nullptr, 0, 0, (const float*)(ws + WS_HSCALE), (const float*)(ws + WS_WSCALE) + (size_t)(L) * FF, nullptr, (unsigned*)(ws + WS_CTL) + CW_ROWMAX + (size_t)(L) * M}; \
        GEMM_PHASE_I8W(pg8::EpiBf16<1>, HB, (signed char*)(ws + WS_WUP) + (size_t)(L) * FF * D, FF, D / 2, E_, WGM_UP); } while (0)
#define DOWN_PHASE(L) do { phase_quant_hidden(lds, DYN_CNT(ws, 0 + (L)), U, (const unsigned*)(ws + WS_CTL) + CW_ROWMAX + (size_t)(L) * M, (signed char*)(scr + SCR_UQ), (float*)(ws + WS_ASCALE)); xcd_barrier(bar); \
        pg8::EpiBf16<0> E_{MX, D, nullptr, 0, 0, (const float*)(ws + WS_ASCALE), (const float*)(ws + WS_WSCALE_DN) + (size_t)(L) * D, (const int*)(ws + WS_CTL) + CW_CS_DN + (size_t)(L) * D, nullptr}; \
        GEMM_PHASE_I8W(pg8::EpiBf16<0>, scr + SCR_UQ, (signed char*)(ws + WS_WDN) + (size_t)(L) * D * FF, D, FF / 2, E_, WGM_DN); } while (0)
#define MLP_PHASES(P, L, XIN, GNEXT, HOUT, QM) do { \
    if (IN(P)) UP_PHASE(L); \
    SEAM(P); \
    if (IN((P) + 1)) DOWN_PHASE(L); \
    SEAM((P) + 1); \
    if (IN((P) + 2)) { if ((QM) == 1) RES_PHASE_Q(XIN, MX, args.in[4] + (size_t)(L) * D, xo, GNEXT); else if ((QM) == 2) phase_res<3, false, false>(lds, XIN, MX, args.in[4] + (size_t)(L) * D, xo, GNEXT, HOUT, (signed char*)(ws + WS_HQ2), (float*)(ws + WS_HSCALE)); else RES_PHASE(XIN, MX, args.in[4] + (size_t)(L) * D, xo, GNEXT, HOUT); } \
    SEAM((P) + 2); } while (0)

#define LRU_PHASES(P, L, J, XIN, XF32) do { \
    bf16* Gb = (bf16*)(scr + SCR_G); bf16* XP = (bf16*)(scr + SCR_XP); bf16* XBp = (bf16*)(scr + SCR_XB); bf16* LAp = (bf16*)(scr + SCR_LA); bf16* INPp = (bf16*)(scr + SCR_INP); bf16* Yp = (bf16*)(scr + SCR_Y); \
    float* SUML = (float*)(scr + SCR_SUML); float* HEND = (float*)(scr + SCR_HEND); \
    if (IN(P)) { pg8::EpiBf16<2> E_{Gb, RW, args.in[6] + (size_t)(J) * 2 * RW, RW, (size_t)(SCR_XP - SCR_G) / 2, (const float*)(ws + WS_HSCALE), (const float*)(ws + WS_WSCALE_LIN) + (size_t)(J) * 2 * RW, nullptr, nullptr}; \
            GEMM_PHASE_I8(pg8::EpiBf16<2>, HB, (signed char*)(ws + WS_WLIN) + (size_t)(J) * 2 * RW * D * 2, 2 * RW, D / 2, E_); } \
    SEAM(P); \
    if (IN((P) + 1)) for (int rep_ = 0; rep_ < REP_THIN; ++rep_) phase_conv(XP, args.in[7] + (size_t)(J) * 4 * RW, args.in[8] + (size_t)(J) * RW, XBp); \
    SEAM((P) + 1); \
    if (IN((P) + 2)) { pg8::EpiGate E_{XBp, LAp, INPp, args.in[10] + (size_t)(J) * RW, args.in[12] + (size_t)(J) * RW, (const float*)(ws + WS_SP8) + (size_t)(J) * RW}; \
        GEMM_PHASE(pg8::EpiGate, XBp, (bf16*)(ws + WS_WGATE) + (size_t)(J) * NGATE * BWP, NGATE, BWP, RWP, BWP, E_, 3, BWP); } \
    SEAM((P) + 2); \
    if (IN((P) + 3)) for (int rep_ = 0; rep_ < REP_THIN; ++rep_) phase_scan1(LAp, INPp, SUML, HEND); \
    SEAM((P) + 3); \
    if (IN((P) + 4)) for (int rep_ = 0; rep_ < REP_THIN; ++rep_) phase_scan2(LAp, INPp, SUML, HEND, Gb, Yp); \
    SEAM((P) + 4); \
    if (IN((P) + 5)) { pg8::EpiBf16<0> E_{MX, D, args.in[15] + (size_t)(J) * D, 0, 0, nullptr, nullptr, nullptr, nullptr}; GEMM_PHASE(pg8::EpiBf16<0>, Yp, (bf16*)(ws + WS_WLOUT) + (size_t)(J) * D * RW, D, RW, RW, RW, E_, 0, 0); } \
    SEAM((P) + 5); \
    if (IN((P) + 6)) phase_res<2, XF32, false>(lds, XIN, MX, args.in[2] + (size_t)(L) * D, xo, args.in[3] + (size_t)(L) * D, nullptr, (signed char*)HB, (float*)(ws + WS_HSCALE)); \
    SEAM((P) + 6); } while (0)

    bf16* Qb = (bf16*)(scr + SCR_Q); bf16* Kb = (bf16*)(scr + SCR_K); bf16* Vb = (bf16*)(scr + SCR_V); bf16* Ob = (bf16*)(scr + SCR_O);

    LRU_PHASES(1, 0, 0, x_in, true);
    MLP_PHASES(8, 0, xo, args.in[1] + (size_t)1 * D, HB, 1);

    if (IN(11)) { pg8::EpiBf16<0> E_{Qb, D, nullptr, D, (size_t)(SCR_K - SCR_Q) / 2, (const float*)(ws + WS_HSCALE), (const float*)(ws + WS_WSCALE_SQKV), nullptr, nullptr}; GEMM_PHASE_I8(pg8::EpiBf16<0>, HB, (signed char*)(ws + WS_WSQKV), 3 * D, D / 2, E_); }
    SEAM(11);
    if (IN(12)) for (int rep_ = 0; rep_ < REP_ATT; ++rep_) {
        if (tid_() == 0) { ((volatile LAS unsigned*)(lds + att::OFF_FLAG))[0] = 0u; ((volatile LAS unsigned*)(lds + att::OFF_FLAG))[1] = 0u; }
        __syncthreads();
        unsigned token = 0u;
        for (int u = bx; u < BATCH * NH * 16; u += G) { const int lu = u >> 3, k = lu >> 4, qb = 15 - (lu & 15), bh = 8 * k + (u & 7);
            att::sb_unit((LAS char*)lds, Qb, Kb, Vb, Ob, bh / NH, bh % NH, qb, token); }
    }
    SEAM(12);
    if (IN(13)) { phase_quant_rows<16>(Ob, (signed char*)(scr + SCR_OQ), (float*)(ws + WS_ASCALE)); xcd_barrier(bar);
        pg8::EpiBf16<0> E_{MX, D, nullptr, 0, 0, (const float*)(ws + WS_ASCALE), (const float*)(ws + WS_WSCALE_WO), nullptr, nullptr}; GEMM_PHASE_I8(pg8::EpiBf16<0>, scr + SCR_OQ, (signed char*)(ws + WS_WSO), D, D / 2, E_); }
    SEAM(13);
    if (IN(14)) RES_PHASE_Q(xo, MX, args.in[2] + (size_t)1 * D, xo, args.in[3] + (size_t)1 * D);
    SEAM(14);
    MLP_PHASES(15, 1, xo, args.in[1] + (size_t)2 * D, HB, 1);

    if (IN(18)) { pg8::EpiBf16<0> E_{Qb, D, nullptr, D, (size_t)(SCR_K - SCR_Q) / 2, (const float*)(ws + WS_HSCALE), (const float*)(ws + WS_WSCALE_MKV), nullptr, nullptr}; GEMM_PHASE_I8(pg8::EpiBf16<0>, HB, (signed char*)(ws + WS_WMQKV), 3 * D, D / 2, E_); }
    SEAM(18);
    if (IN(19)) for (int rep_ = 0; rep_ < REP_THIN; ++rep_) phase_kmean(Kb, (bf16*)(scr + SCR_KMH), (bf16*)(scr + SCR_KML));
    SEAM(19);
    if (IN(20)) for (int rep_ = 0; rep_ < REP_ATT; ++rep_) {
        const bf16* KMH = (const bf16*)(scr + SCR_KMH); const bf16* KML = (const bf16*)(scr + SCR_KML);
        for (int u2 = bx * 2; u2 < BATCH * NH * 16; u2 += G * 2) {
#pragma nounroll
            for (int pass = 0; pass < 2; ++pass) { const int u = u2 >> 1, lu = u >> 3, k = lu >> 3, p = lu & 7, bh = 8 * k + (u & 7);
                att::moba_unit((LAS char*)lds, Qb, Kb, Vb, Ob, KMH, KML, args.in[20], bh / NH, bh % NH, pass ? p : 15 - p); } }
    }
    SEAM(20);
    if (IN(21)) { phase_quant_rows<16>(Ob, (signed char*)(scr + SCR_OQ), (float*)(ws + WS_ASCALE)); xcd_barrier(bar);
        pg8::EpiBf16<0> E_{MX, D, nullptr, 0, 0, (const float*)(ws + WS_ASCALE), (const float*)(ws + WS_WSCALE_WO) + D, nullptr, nullptr}; GEMM_PHASE_I8(pg8::EpiBf16<0>, scr + SCR_OQ, (signed char*)(ws + WS_WMO), D, D / 2, E_); }
    SEAM(21);
    if (IN(22)) RES_PHASE_Q(xo, MX, args.in[2] + (size_t)2 * D, xo, args.in[3] + (size_t)2 * D);
    SEAM(22);
    MLP_PHASES(23, 2, xo, args.in[1] + (size_t)3 * D, HB, 1);

    LRU_PHASES(26, 3, 1, xo, false);
    if (IN(33)) UP_PHASE(3);
    SEAM(33);
    if (IN(34)) DOWN_PHASE(3);
    SEAM(34);
    if (IN(35)) phase_res<0, false, true>(lds, xo, MX, args.in[4] + (size_t)3 * D, args.out, nullptr, nullptr, nullptr, nullptr);
#undef IN
#undef SEAM
}
#ifndef N_LAUNCH_MODE
#define N_LAUNCH_MODE 1
#endif
extern "C" void kernel_launch(void* const* d_in, const int* in_sizes, int n_in, void* d_out, int out_size, void* d_ws, size_t ws_size, hipStream_t stream) {
    static int grid = 0;
    if (grid == 0) {
        if (n_in != 23 || in_sizes[0] != M * D || out_size != M * D || ws_size < WS_END) { fprintf(stderr, "kernel_launch: shape/workspace mismatch (n_in %d, in0 %d, out %d, ws %zu, need %zu)\n", n_in, n_in > 0 ? in_sizes[0] : -1, out_size, ws_size, (size_t)WS_END); grid = -1; return; }
        int dev = 0, cus = 0, per_cu = 0;
        if (hipGetDevice(&dev) != hipSuccess || hipDeviceGetAttribute(&cus, hipDeviceAttributeMultiprocessorCount, dev) != hipSuccess) { grid = -1; return; }
        if (hipFuncSetAttribute((const void*)trunk_fwd, hipFuncAttributeMaxDynamicSharedMemorySize, LDS_BYTES) != hipSuccess) { fprintf(stderr, "kernel_launch: hipFuncSetAttribute failed\n"); grid = -1; return; }
        if (hipOccupancyMaxActiveBlocksPerMultiprocessor(&per_cu, (const void*)trunk_fwd, NTHREADS, LDS_BYTES) != hipSuccess || per_cu < 1) fprintf(stderr, "kernel_launch: occupancy query says %d\n", per_cu);
        (void)hipGetLastError();
        grid = cus;
    }
    if (grid < 0) return;
    (void)hipMemsetAsync((char*)d_ws + WS_CTL, 0, CTL_ZERO_BYTES, stream);
    Args a{};
    for (int i = 0; i < 23; ++i) a.in[i] = (const float*)d_in[i];
    a.out = (float*)d_out; a.ws = (unsigned char*)d_ws;
#if N_LAUNCH_MODE == 1
    a.ph_lo = 0; a.ph_hi = NPHASES;
    hipLaunchKernelGGL(trunk_fwd, dim3(grid), dim3(NTHREADS), LDS_BYTES, stream, a);
#else
    for (int p = 0; p < NPHASES; ++p) { a.ph_lo = p; a.ph_hi = p + 1; hipLaunchKernelGGL(trunk_fwd, dim3(grid), dim3(NTHREADS), LDS_BYTES, stream, a);
#ifdef DEBUG_CHECKS
        debug_checks_after(p, a, stream);
#endif
    }
#ifdef DEBUG_CHECKS
    debug_finish(a, stream);
#endif
#endif
}
```

```cpp
#define N_LAUNCH_MODE 1
#include <hip/hip_runtime.h>
#include <cstdio>
#include <cstdint>

#define LAS __attribute__((address_space(3)))
#define GAS __attribute__((address_space(1)))
typedef unsigned short bf16;
typedef short bf16x8 __attribute__((ext_vector_type(8)));
typedef short s16x4 __attribute__((ext_vector_type(4)));
typedef float f32x2 __attribute__((ext_vector_type(2)));
typedef float f32x4 __attribute__((ext_vector_type(4)));
typedef float f32x16 __attribute__((ext_vector_type(16)));
typedef unsigned u32x2 __attribute__((ext_vector_type(2)));
typedef unsigned u32x4 __attribute__((ext_vector_type(4)));
typedef int i32x4 __attribute__((ext_vector_type(4)));

__device__ __forceinline__ unsigned cvt_pk_bf16(float lo, float hi) { unsigned r; asm volatile("v_cvt_pk_bf16_f32 %0, %1, %2" : "=v"(r) : "v"(lo), "v"(hi)); return r; }
__device__ __forceinline__ float bf_lo(unsigned w) { return __uint_as_float(w << 16); }
__device__ __forceinline__ float bf_hi(unsigned w) { return __uint_as_float(w & 0xffff0000u); }
__device__ __forceinline__ float bf2f(bf16 b) { return __uint_as_float(((unsigned)b) << 16); }
__device__ __forceinline__ float ex2(float x) { return __builtin_amdgcn_exp2f(x); }
__device__ __forceinline__ float lg2(float x) { return __builtin_amdgcn_logf(x); }
__device__ __forceinline__ float rcpf_(float x) { return __builtin_amdgcn_rcpf(x); }
constexpr float LOG2E = 1.4426950408889634f, LN2 = 0.6931471805599453f;
__device__ __forceinline__ float sigmoidf_(float v) { return rcpf_(1.0f + ex2(-v * LOG2E)); }
__device__ __forceinline__ int tid_() { int t = threadIdx.x; asm volatile("" : "+v"(t)); return t; }
__device__ __forceinline__ int bx_() { int b = blockIdx.x; asm volatile("" : "+s"(b)); return b; }
__device__ __forceinline__ int gdim_() { int g = gridDim.x; asm volatile("" : "+s"(g)); return g; }

#ifndef PG8_WGM
#define PG8_WGM 8
#endif
namespace pg8 {
constexpr int BM = 256, BK = 64, HALF = 128, HTB = HALF * BK * 2  , STAGE_BYTES = 8 * HTB, NXCD = 8, WGM = PG8_WGM;
__host__ __device__ __forceinline__ int lds_byte(int r, int c) { const int st = (r >> 4) * 2 + (c >> 5), rr = r & 15, cc = c & 31, ob = rr * 64 + cc * 2; return st * 1024 + (ob ^ (((ob >> 9) & 1) << 5)); }
__host__ __device__ __forceinline__ void stage_rc(int b, int& R, int& C) { const int st = b / 1024, sb = b % 1024, swz = sb ^ (((sb >> 9) & 1) << 5); R = (st >> 1) * 16 + swz / 64; C = (st & 1) * 32 + (swz % 64) / 2; }
__host__ __device__ __forceinline__ int perm32(int rho) { const int n = rho >> 4, i = rho & 15; return 8 * (i >> 2) + 4 * n + (i & 3); }

struct Unit { int pm, pn, ak; };
struct Gemm { const bf16* A; const bf16* Bt; int M, N, K, lda, ldb; };

struct StaticOrder {
    int nM, nN, nwg, G, c, grp;
    int akstep, wgm;
    __host__ __device__ void init(int M, int N, int G_, int c_, int grp_ = 0, int akstep_ = 0, int wgm_ = WGM) { nM = M / BM; nN = N / BM; nwg = nM * nN; G = G_; c = c_; grp = grp_; akstep = akstep_; wgm = wgm_; }
    __host__ __device__ bool next(int i, Unit& u) const {
        const long L = (long)i * G + c; if (L >= nwg) return false;
        int wgid = (int)L; { const int q = nwg / NXCD, r = nwg % NXCD, xcd = wgid % NXCD, off = wgid / NXCD; wgid = (xcd < r ? xcd * (q + 1) : r * (q + 1) + (xcd - r) * q) + off; }
        const int nig = wgm * nN, gid = wgid / nig, fm = gid * wgm, gsz = (nM - fm) < wgm ? (nM - fm) : wgm;
        u.pm = fm + ((wgid % nig) % gsz); u.pn = (wgid % nig) / gsz; u.ak = grp ? (u.pn / grp) * akstep : 0; return true;
    }
    __device__ __forceinline__ void a_ready(const Unit&) const {}
    __device__ __forceinline__ void done(const Unit&) const {}
};

__device__ __forceinline__ float gelu_tanh(float x) {
    const float u = 1.5957691216057308f * (x + 0.044715f * x * x * x);
    return x * rcpf_(1.0f + ex2(-u * LOG2E));
}
__device__ __forceinline__ f32x4 tofloat(const f32x4& v) { return v; }
__device__ __forceinline__ f32x4 tofloat(const i32x4& v) { return __builtin_convertvector(v, f32x4); }
template <int ACT> struct EpiBf16 {
    static constexpr bool PERM = true, AFTER_DRAIN = false;
    bf16* O; int ldc; const float* bias; int split_cols; size_t split_stride;
    const float* rscale; const float* cscale;
    const int* coff;
    unsigned* rowmax;
    static constexpr bool LDS_SCALES = true;
    __device__ __forceinline__ void stage_ptrs(const Unit& u, int tid, const float*& pa, const float*& pb) const {
        if (tid < 256) { pa = rscale + u.pm * BM + tid; pb = coff ? (const float*)(coff + u.pn * BM + tid) : pa; }
        else { pa = cscale + u.pn * BM + tid - 256; pb = bias ? bias + u.pn * BM + tid - 256 : pa; }
    }
    __device__ __forceinline__ bool staged() const { return cscale != nullptr; }
    template <class AV> __device__ __forceinline__ void operator()(const AV (&acc)[2][2][4][2], const Unit& u, int wr, int wc, int fr, int fq, const LAS float* sl) const {
        const int row0 = u.pm * BM + wr * 64 + fr; int colt = u.pn * BM; bf16* base = O; int t = 0;
        if (split_cols) { t = colt / split_cols; base += (size_t)t * split_stride; colt -= t * split_cols; }
        const int col0 = colt + wc * 32 + 8 * fq, lcol0 = wc * 32 + 8 * fq;
        f32x4 bv[2][2];
#pragma unroll
        for (int bj = 0; bj < 2; ++bj)
#pragma unroll
            for (int n = 0; n < 2; ++n) bv[bj][n] = !bias ? (f32x4){0.f, 0.f, 0.f, 0.f} : cscale ? *(const LAS f32x4*)(sl + 768 + lcol0 + bj * HALF + 4 * n) : *(const f32x4*)(bias + u.pn * BM + lcol0 + bj * HALF + 4 * n);
        f32x4 cs[2][2];
        if (cscale) {
#pragma unroll
            for (int bj = 0; bj < 2; ++bj)
#pragma unroll
                for (int n = 0; n < 2; ++n) cs[bj][n] = *(const LAS f32x4*)(sl + 256 + lcol0 + bj * HALF + 4 * n); }
        f32x4 co[2][2];
        if (coff) {
#pragma unroll
            for (int bj = 0; bj < 2; ++bj)
#pragma unroll
                for (int n = 0; n < 2; ++n) { const i32x4 ci = *(const LAS i32x4*)(sl + 512 + lcol0 + bj * HALF + 4 * n); co[bj][n] = __builtin_convertvector(ci, f32x4) * 128.f; } }
#pragma unroll
        for (int ai = 0; ai < 2; ++ai) { float rm4[4];
#pragma unroll
            for (int m = 0; m < 4; ++m) { bf16* rowp = base + (size_t)(row0 + ai * HALF + m * 16) * ldc + col0;
                const float rsc = cscale ? sl[wr * 64 + fr + ai * HALF + m * 16] : 1.f; float rmx = 0.f;
#pragma unroll
                for (int bj = 0; bj < 2; ++bj) { f32x4 v0 = tofloat(acc[ai][bj][m][0]), v1 = tofloat(acc[ai][bj][m][1]);
                    if (coff) { v0 = v0 + co[bj][0]; v1 = v1 + co[bj][1]; }
                    if (cscale) { v0 = v0 * rsc * cs[bj][0]; v1 = v1 * rsc * cs[bj][1]; }
                    v0 = v0 + bv[bj][0]; v1 = v1 + bv[bj][1];
                    if (ACT == 1) {
#pragma unroll
                        for (int j = 0; j < 4; ++j) { const float a = fmaxf(v0[j], 0.f), b = fmaxf(v1[j], 0.f); v0[j] = a * a; v1[j] = b * b; } }
                    if (ACT == 2) { if (t == 0) {
#pragma unroll
                        for (int j = 0; j < 4; ++j) { v0[j] = gelu_tanh(v0[j]); v1[j] = gelu_tanh(v1[j]); } } }
                    u32x4 w; w.x = cvt_pk_bf16(v0[0], v0[1]); w.y = cvt_pk_bf16(v0[2], v0[3]); w.z = cvt_pk_bf16(v1[0], v1[1]); w.w = cvt_pk_bf16(v1[2], v1[3]);
                    *(u32x4*)(rowp + bj * HALF) = w;
                    if (rowmax) rmx = fmaxf(rmx, fmaxf(fmaxf(fmaxf(v0[0], v0[1]), fmaxf(v0[2], v0[3])), fmaxf(fmaxf(v1[0], v1[1]), fmaxf(v1[2], v1[3])))); }
                if (rowmax) { rmx = fmaxf(rmx, __shfl_xor(rmx, 16)); rmx = fmaxf(rmx, __shfl_xor(rmx, 32)); rm4[m] = rmx; } }
            if (rowmax) { const float r = fq == 0 ? rm4[0] : fq == 1 ? rm4[1] : fq == 2 ? rm4[2] : rm4[3]; atomicMax(rowmax + row0 + ai * HALF + fq * 16, __float_as_uint(r)); } }
    }
};
struct EpiGate {
    static constexpr bool PERM = false, AFTER_DRAIN = false;
    const bf16* XB; bf16* LA; bf16* INP; const float* bga; const float* bgx; const float* sp8;
    static constexpr bool LDS_SCALES = false;
    __device__ __forceinline__ void stage_ptrs(const Unit&, int, const float*&, const float*&) const {}
    __device__ __forceinline__ bool staged() const { return false; }
    __device__ __forceinline__ void operator()(const f32x4 (&acc)[2][2][4][2], const Unit& u, int wr, int wc, int fr, int fq, const LAS float*) const {
        const int row0 = u.pm * BM + wr * 64 + fr; const int nb = u.pn / 3, t3 = u.pn - 3 * nb;
#pragma unroll
        for (int bj = 0; bj < 2; ++bj) {
            const int cb = 128 * t3 + 64 * bj + 16 * wc + 4 * fq;
            if (cb < 336) {
                const int c = nb * 336 + cb;
                const f32x4 ba = *(const f32x4*)(bga + c), bx = *(const f32x4*)(bgx + c), sp = *(const f32x4*)(sp8 + c);
#pragma unroll
                for (int ai = 0; ai < 2; ++ai)
#pragma unroll
                    for (int m = 0; m < 4; ++m) { const size_t row = (size_t)(row0 + ai * HALF + m * 16);
                        const u32x2 xw = *(const u32x2*)(XB + row * 6144 + nb * 384 + cb);
                        const float xb[4] = {bf_lo(xw.x), bf_hi(xw.x), bf_lo(xw.y), bf_hi(xw.y)};
                        float la[4], ip[4];
#pragma unroll
                        for (int j = 0; j < 4; ++j) { const float r = sigmoidf_(acc[ai][bj][m][0][j] + ba[j]), ig = sigmoidf_(acc[ai][bj][m][1][j] + bx[j]);
                            const float l = -r * sp[j]; la[j] = l; const float x2 = 2.f * l;
                            const float om = x2 > -0.002f ? -x2 * (1.f + 0.5f * x2) : 1.f - ex2(x2 * LOG2E);
                            ip[j] = __builtin_amdgcn_sqrtf(fmaxf(om, 0.f)) * ig * xb[j]; }
                        u32x2 wl, wi; wl.x = cvt_pk_bf16(la[0], la[1]); wl.y = cvt_pk_bf16(la[2], la[3]); wi.x = cvt_pk_bf16(ip[0], ip[1]); wi.y = cvt_pk_bf16(ip[2], ip[3]);
                        *(u32x2*)(LA + row * 5376 + c) = wl; *(u32x2*)(INP + row * 5376 + c) = wi; }
            }
        }
    }
};

template <bool I8> struct AccT { typedef f32x4 type; };
template <> struct AccT<true> { typedef i32x4 type; };
constexpr int EPI_SL_OFF = 131072 + 4096;
template <class Epi, class Sched, bool ALIGN_EPI = true, bool I8 = false>
__device__ __forceinline__ void gemm_phase(LAS unsigned char* lds, const Gemm g, const Sched& S, const Epi& E) {
    const int tid = tid_(), wid = __builtin_amdgcn_readfirstlane(tid >> 6), lane = tid & 63, wr = wid >> 2, wc = wid & 3, fr = lane & 15, fq = lane >> 4;
    const int K = g.K, nt = K / BK;
    unsigned voffA[2], voffB[2];
#pragma unroll
    for (int i = 0; i < 2; ++i) { int R, C; stage_rc(tid * 16 + i * 8192, R, C); const int Rb = Epi::PERM ? ((R & ~31) + perm32(R & 31)) : R;
        voffA[i] = (unsigned)(R * g.lda + C) * 2u; voffB[i] = (unsigned)(Rb * g.ldb + C) * 2u; }
    const size_t kstep = (size_t)(BK * 2);
    const size_t hA = (size_t)HALF * g.lda * 2, hB = (size_t)HALF * g.ldb * 2;
    const size_t tA = 2 * hA, tB = 2 * hB;
    const unsigned ldsw = (unsigned)wid * 1024u;
    const int aoff = lds_byte(wr * 64 + fr, fq * 8), boff = lds_byte(wc * 32 + fr, fq * 8);
#define PG8_SA(b, h) (((b) * 2 + (h)) * HTB)
#define PG8_SB(b, h) ((4 + (b) * 2 + (h)) * HTB)
#define PG8_STAGE(bufoff, gbase, voff) do { _Pragma("unroll") for (int _i = 0; _i < 2; ++_i) \
        __builtin_amdgcn_global_load_lds((const unsigned*)((const char*)(gbase) + (voff)[_i]), (LAS unsigned*)(lds + (bufoff) + ldsw + _i * 8192), 16, 0, 0); } while (0)
#define PG8_LDA(dst, b, h) do { _Pragma("unroll") for (int m = 0; m < 4; ++m) _Pragma("unroll") for (int k = 0; k < 2; ++k) dst[m][k] = *(const LAS bf16x8*)(lds + PG8_SA(b, h) + aoff + m * 2048 + k * 1024); } while (0)
#define PG8_LDB(dst, b, h) do { _Pragma("unroll") for (int n = 0; n < 2; ++n) _Pragma("unroll") for (int k = 0; k < 2; ++k) dst[n][k] = *(const LAS bf16x8*)(lds + PG8_SB(b, h) + boff + n * 2048 + k * 1024); } while (0)
#define PG8_MMA(ai, bj, At, Bt) do { __builtin_amdgcn_s_setprio(1); _Pragma("unroll") for (int m = 0; m < 4; ++m) _Pragma("unroll") for (int n = 0; n < 2; ++n) _Pragma("unroll") for (int k = 0; k < 2; ++k) \
        { if constexpr (I8) acc[ai][bj][m][n] = __builtin_amdgcn_mfma_i32_16x16x64_i8(__builtin_bit_cast(i32x4, Bt[n][k]), __builtin_bit_cast(i32x4, At[m][k]), acc[ai][bj][m][n], 0, 0, 0); \
          else acc[ai][bj][m][n] = __builtin_amdgcn_mfma_f32_16x16x32_bf16(Bt[n][k], At[m][k], acc[ai][bj][m][n], 0, 0, 0); } __builtin_amdgcn_s_setprio(0); } while (0)
#define PG8_WAIT_V(n) asm volatile("s_waitcnt vmcnt(" #n ")" ::: "memory")
#define PG8_WAIT_L(n) asm volatile("s_waitcnt lgkmcnt(" #n ")" ::: "memory")
#define PG8_BAR __builtin_amdgcn_s_barrier()
#define PG8_SCHED __builtin_amdgcn_sched_barrier(0)
    Unit cur, nxt; int ui = 0;
    if (!S.next(0, cur)) return;
    LAS float* sl = (LAS float*)(lds + EPI_SL_OFF); float sva = 1.f, svb = 0.f;
    typedef typename AccT<I8>::type accv;
    accv acc[2][2][4][2];
#pragma unroll
    for (int a = 0; a < 2; ++a)
#pragma unroll
        for (int b = 0; b < 2; ++b)
#pragma unroll
            for (int m = 0; m < 4; ++m)
#pragma unroll
                for (int n = 0; n < 2; ++n) acc[a][b][m][n] = accv{};
    bf16x8 At[4][2], B0[2][2], B1[2][2];
    const char* cA = (const char*)g.A + (size_t)cur.pm * tA + (size_t)cur.ak * 2; const char* cB = (const char*)g.Bt + (size_t)cur.pn * tB;
    S.a_ready(cur);
    PG8_STAGE(PG8_SB(0, 0), cB, voffB); PG8_STAGE(PG8_SB(0, 1), cB + hB, voffB); PG8_STAGE(PG8_SA(0, 0), cA, voffA); PG8_STAGE(PG8_SA(0, 1), cA + hA, voffA);
    if (wr == 1) PG8_BAR;
    PG8_WAIT_V(2); PG8_BAR;
    PG8_STAGE(PG8_SB(1, 0), cB + kstep, voffB); PG8_STAGE(PG8_SA(1, 0), cA + kstep, voffA); PG8_STAGE(PG8_SB(1, 1), cB + hB + kstep, voffB);
    PG8_WAIT_V(6); PG8_BAR;
    for (;;) {
        const bool has_next = S.next(ui + 1, nxt);
        const char* nA = has_next ? (const char*)g.A + (size_t)nxt.pm * tA + (size_t)nxt.ak * 2 : cA; const char* nB = has_next ? (const char*)g.Bt + (size_t)nxt.pn * tB : cB;
#pragma nounroll
        for (int t = 0; t < nt; t += 2) {
            const bool last = (t == nt - 2);
            if constexpr (Epi::LDS_SCALES) { if (t == 0 && E.staged()) { const float* pa; const float* pb; E.stage_ptrs(cur, tid, pa, pb);
                asm volatile("global_load_dword %0, %2, off\n\tglobal_load_dword %1, %3, off" : "=&v"(sva), "=&v"(svb) : "v"(pa), "v"(pb) : "memory"); } }
            const char* a1 = cA + (size_t)(t + 1) * kstep;
            const char* a2 = last ? nA : cA + (size_t)(t + 2) * kstep; const char* b2 = last ? nB : cB + (size_t)(t + 2) * kstep;
            const char* a3 = a2 + kstep; const char* b3 = b2 + kstep;
            if (last && has_next) S.a_ready(nxt);
            PG8_LDB(B0, 0, 0); PG8_LDB(B1, 0, 1); PG8_SCHED; PG8_LDA(At, 0, 0); PG8_STAGE(PG8_SA(1, 1), a1 + hA, voffA);
            PG8_WAIT_V(8); PG8_WAIT_L(0); PG8_BAR; PG8_MMA(0, 0, At, B0); PG8_MMA(0, 1, At, B1); PG8_BAR; PG8_SCHED;
            PG8_LDA(At, 0, 1); PG8_STAGE(PG8_SB(0, 0), b2, voffB); PG8_STAGE(PG8_SB(0, 1), b2 + hB, voffB); PG8_STAGE(PG8_SA(0, 0), a2, voffA);
            PG8_WAIT_V(8); PG8_WAIT_L(0); PG8_BAR; PG8_MMA(1, 0, At, B0); PG8_MMA(1, 1, At, B1); PG8_BAR; PG8_SCHED;
            PG8_LDB(B0, 1, 0); PG8_LDB(B1, 1, 1); PG8_SCHED; PG8_LDA(At, 1, 0); PG8_STAGE(PG8_SA(0, 1), a2 + hA, voffA);
            PG8_WAIT_V(8); PG8_WAIT_L(0); PG8_BAR; PG8_MMA(0, 0, At, B0); PG8_MMA(0, 1, At, B1); PG8_BAR; PG8_SCHED;
            PG8_LDA(At, 1, 1); PG8_STAGE(PG8_SB(1, 0), b3, voffB); PG8_STAGE(PG8_SB(1, 1), b3 + hB, voffB); PG8_STAGE(PG8_SA(1, 0), a3, voffA);
            PG8_WAIT_V(8); PG8_WAIT_L(0); PG8_BAR; PG8_MMA(1, 0, At, B0); PG8_MMA(1, 1, At, B1); PG8_BAR; PG8_SCHED;
            if constexpr (Epi::LDS_SCALES) { if (t == 0 && E.staged()) { sl[tid] = sva; sl[512 + tid] = svb; } }
        }
        if constexpr (ALIGN_EPI) { if (wr == 0) PG8_BAR; }
        E(acc, cur, wr, wc, fr, fq, sl); S.done(cur);
        if (!has_next) break;
#pragma unroll
        for (int a = 0; a < 2; ++a)
#pragma unroll
            for (int b = 0; b < 2; ++b)
#pragma unroll
                for (int m = 0; m < 4; ++m)
#pragma unroll
                    for (int n = 0; n < 2; ++n) acc[a][b][m][n] = accv{};
        cur = nxt; cA = nA; cB = nB; ++ui;
        if constexpr (ALIGN_EPI) { if (wr == 1) PG8_BAR; }
    }
    PG8_WAIT_V(0);
    if constexpr (!ALIGN_EPI) { if (wr == 0) PG8_BAR; }
    PG8_BAR;
#undef PG8_SA
#undef PG8_SB
#undef PG8_STAGE
#undef PG8_LDA
#undef PG8_LDB
#undef PG8_MMA
#undef PG8_WAIT_V
#undef PG8_WAIT_L
#undef PG8_BAR
#undef PG8_SCHED
}
}
constexpr int BATCH = 4, SEQ = 4096, D = 4096, NH = 32, HD = 128, FF = 16384, DEPTH = 4;
constexpr int M = BATCH * SEQ;
constexpr int RW = 5376, NBLK = 16, BW = 336, BWP = 384, RWP = NBLK * BWP;
constexpr int NGATE = NBLK * 768;
constexpr int CHUNK = 64, NCHUNK = SEQ / CHUNK;
constexpr float EPS = 1e-6f;
constexpr int NWAVES = 8, NTHREADS = 512;

constexpr size_t MiB = 1u << 20;
constexpr size_t WS_CTL = 0, CTL_ZERO_BYTES = 2 * MiB;
constexpr size_t WS_WLIN = 2 * MiB;
constexpr size_t WS_WLOUT = WS_WLIN + 168 * MiB;
constexpr size_t WS_WGATE = WS_WLOUT + 84 * MiB;
constexpr size_t WS_WSQKV = WS_WGATE + 18 * MiB;
constexpr size_t WS_WSO = WS_WSQKV + 96 * MiB;
constexpr size_t WS_WMQKV = WS_WSO + 32 * MiB;
constexpr size_t WS_WMO = WS_WMQKV + 96 * MiB;
constexpr size_t WS_WUP = WS_WMO + 32 * MiB;
constexpr size_t WS_WDN = WS_WUP + 512 * MiB;
constexpr size_t WS_SP8 = WS_WDN + 512 * MiB;
constexpr size_t WS_WSCALE_WO = WS_SP8 + 320 * 1024;
constexpr size_t WS_WSCALE_MKV = WS_SP8 + 128 * 1024;
constexpr size_t WS_WSCALE_SQKV = WS_SP8 + 64 * 1024;
constexpr size_t WS_WSCALE_DN = WS_SP8 + 896 * 1024;
constexpr size_t WS_ASCALE = WS_SP8 + 192 * 1024;
constexpr size_t WS_WSCALE_LIN = WS_SP8 + 768 * 1024;
constexpr size_t WS_HSCALE = WS_SP8 + 256 * 1024, WS_WSCALE = WS_SP8 + 512 * 1024;
constexpr size_t WS_HB = WS_SP8 + 1 * MiB;
constexpr size_t WS_MX = WS_HB + 128 * MiB;
constexpr size_t WS_SCR = WS_MX + 128 * MiB;
constexpr size_t SCR_UQ = 512 * MiB;
constexpr size_t SCR_U = 0;
constexpr size_t SCR_G = 0, SCR_XP = 168 * MiB, SCR_XB = 336 * MiB, SCR_LA = 528 * MiB, SCR_INP = 696 * MiB, SCR_Y = 864 * MiB;
constexpr size_t SCR_SUML = 1032 * MiB, SCR_HEND = 1038 * MiB;
constexpr size_t SCR_Q = 0, SCR_K = 128 * MiB, SCR_V = 256 * MiB, SCR_O = 384 * MiB;
constexpr size_t SCR_OQ = 520 * MiB;
constexpr size_t SCR_KMH = 512 * MiB, SCR_KML = 513 * MiB;
constexpr size_t WS_X16 = WS_SCR + 1044 * MiB;
constexpr size_t WS_HQ2 = WS_X16 + 128 * MiB;
constexpr size_t WS_YQ = WS_HQ2 + 64 * MiB;
constexpr size_t WS_END = WS_YQ + 96 * MiB;

constexpr int CW_BAR = 4096;
constexpr int CW_COLMAX_DN = 122880, CW_CS_DN = 139264, CW_ROWMAX = 155648;
constexpr int CW_COLMAX_WO = 241664;
constexpr int CW_COLMAX_MKV = 262144;
constexpr int CW_COLMAX_SQKV = 221184;
constexpr int CW_COLMAX_LIN = 98304;
constexpr int CW_COLMAX = 32768;
constexpr int CW_DYN = 8192;
constexpr int CW_DEAL = 294912;
constexpr int CW_ERR = 16384;

constexpr int RING_BYTES = 131072;
constexpr int LDSCTL_OFF = RING_BYTES;
constexpr int LDS_DYN = LDSCTL_OFF + 8192;
static_assert(pg8::EPI_SL_OFF == LDSCTL_OFF + 4096, "epilogue scale area");
constexpr int LDS_BYTES = 147456;

#define VM_WAIT() asm volatile("s_waitcnt vmcnt(0)" ::: "memory")
#define LDS_WAIT() asm volatile("s_waitcnt lgkmcnt(0)" ::: "memory")

#define XB_TMO      128
#define XB_XCNT(j)  (256  + 64 * (j))
#define XB_XSUB(j)  (1280 + 64 * (j))
#define XB_XGEN(j)  (2304 + 64 * (j))
#define XB_TOP      3328
#define XB_TOPGEN   3392
#define XCD_BAR_WORDS 3456
#define XB_SPIN_CAP (1u << 18)
__device__ __forceinline__ unsigned xb_ld(unsigned* p)              { return __hip_atomic_load(p, __ATOMIC_RELAXED, __HIP_MEMORY_SCOPE_AGENT); }
__device__ __forceinline__ unsigned xb_add(unsigned* p, unsigned v) { return __hip_atomic_fetch_add(p, v, __ATOMIC_RELAXED, __HIP_MEMORY_SCOPE_AGENT); }
__device__ __forceinline__ unsigned xb_xcc_id() { return (unsigned)__builtin_amdgcn_s_getreg((3 << 11) | 20) & 0xFu; }
#define XB_SPIN(cond, bar) do { unsigned _sp = 0; while (cond) { __builtin_amdgcn_s_sleep(1); \
    if ((++_sp & 255u) == 0u) { if (xb_ld(&(bar)[XB_TMO])) break; if (_sp > XB_SPIN_CAP) { atomicAdd(&(bar)[XB_TMO], 1u); break; } } } } while (0)
struct XcdBarrier { unsigned* bar; unsigned x; volatile LAS unsigned* st; };
__device__ __forceinline__ XcdBarrier xcd_barrier_post(unsigned* bar, volatile LAS unsigned* st) {
    XcdBarrier b; b.bar = bar; b.x = xb_xcc_id(); b.st = st;
    if (threadIdx.x == 0) (void)xb_add(&bar[XB_XCNT(b.x)], 1u);
    return b;
}
__device__ __forceinline__ void xcd_barrier_complete(unsigned* bar, unsigned x, unsigned& nloc, unsigned& nx) {
    const unsigned G = gridDim.x * gridDim.y * gridDim.z;
    unsigned sum, cnt, mine, sp = 0u;
    for (;;) {
        sum = 0u; cnt = 0u; mine = 0u;
#pragma unroll
        for (unsigned j = 0; j < 16; ++j) { const unsigned c = xb_ld(&bar[XB_XCNT(j)]); sum += c; cnt += (c > 0u) ? 1u : 0u; mine = (j == x) ? c : mine; }
        if (sum == G) break;
        __builtin_amdgcn_s_sleep(1);
        if ((++sp & 255u) == 0u) { if (xb_ld(&bar[XB_TMO])) break; if (sp > XB_SPIN_CAP) { atomicAdd(&bar[XB_TMO], 1u); break; } }
    }
    nloc = mine > 0u ? mine : 1u; nx = cnt > 0u ? cnt : 1u;
}
__device__ __forceinline__ void xcd_barrier(const XcdBarrier& b) {
    asm volatile("s_waitcnt vmcnt(0)" ::: "memory");
    __syncthreads();
    if (threadIdx.x == 0) {
        unsigned* bar = b.bar;
        __builtin_amdgcn_s_waitcnt(0);
        unsigned nloc = b.st[0], nx = b.st[1];
        if (nloc == 0u) { xcd_barrier_complete(bar, b.x, nloc, nx); b.st[0] = nloc; b.st[1] = nx; }
        const unsigned old = xb_add(&bar[XB_XSUB(b.x)], 1u);
        const unsigned gen = old / nloc;
        if (old + 1u == (gen + 1u) * nloc) {
            __builtin_amdgcn_fence(__ATOMIC_RELEASE, "agent");
            asm volatile("s_waitcnt vmcnt(0)" ::: "memory");
            const unsigned og = xb_add(&bar[XB_TOP], 1u);
            const unsigned tg = og / nx;
            if (og + 1u == (tg + 1u) * nx) xb_add(&bar[XB_TOPGEN], 1u);
            else XB_SPIN(xb_ld(&bar[XB_TOPGEN]) == tg, bar);
            __builtin_amdgcn_fence(__ATOMIC_ACQUIRE, "agent");
            xb_add(&bar[XB_XGEN(b.x)], 1u);
            asm volatile("s_waitcnt vmcnt(0)" ::: "memory");
        } else {
            XB_SPIN(xb_ld(&bar[XB_XGEN(b.x)]) == gen, bar);
            __builtin_amdgcn_fence(__ATOMIC_ACQUIRE, "agent");
            asm volatile("s_waitcnt vmcnt(0)" ::: "memory");
        }
    }
    __syncthreads();
}

__device__ __forceinline__ float wave_sum(float v) {
#pragma unroll
    for (int o = 1; o < 64; o <<= 1) v += __shfl_xor(v, o);
    return v;
}
struct Deal { unsigned* cnt; int g, ngrp, wi, nw; };
__device__ __forceinline__ Deal deal_make(unsigned* ctl, int site, int bx, int G, int wave) {
    Deal d; d.g = min(bx >> 3, 31); d.ngrp = min((G + 7) >> 3, 32); d.cnt = ctl + CW_DEAL + (site * 32 + d.g) * 16; d.wi = (bx - d.g * 8) * NWAVES + wave; d.nw = (d.g == d.ngrp - 1 ? G - d.g * 8 : 8) * NWAVES; return d;
}
__device__ __forceinline__ unsigned deal_issue(const Deal& d, int lane) { unsigned v = 0u; if (lane == 0) v = __hip_atomic_fetch_add(d.cnt, 1u, __ATOMIC_RELAXED, __HIP_MEMORY_SCOPE_AGENT); return v; }
constexpr int QCH = 4;
#define TILE_LOAD(dst, itm) do { const int kb_ = (itm) / nblk, nb_ = (itm) % nblk; const float* wp_ = W + (size_t)(64 * kb_ + (lane >> 5)) * ldw + 32 * nb_ + (lane & 31); \
        _Pragma("unroll") for (int i_ = 0; i_ < 32; ++i_) dst[i_] = wp_[(size_t)(2 * i_) * ldw]; } while (0)
__device__ __forceinline__ void transpose_matrix(const float* W, int K, int N, bf16* WT, LAS float* scr, const Deal d, int lane, int ldw = 0) {
    const int nblk = N / 32, nitems = (K / 64) * nblk; if (ldw == 0) ldw = N;
    int item = (d.wi * d.ngrp + d.g) * QCH; if (item >= nitems) return;
    float tv[32], tn[32]; TILE_LOAD(tv, item);
    unsigned tk = deal_issue(d, lane);
    for (;;) {
        int nxt = item + 1;
        if (nxt % QCH == 0) { nxt = (((int)__builtin_amdgcn_readfirstlane(tk) + d.nw) * d.ngrp + d.g) * QCH; if (nxt < nitems) tk = deal_issue(d, lane); }
        const int kb = item / nblk, nb = item % nblk, k0 = 64 * kb, n0 = 32 * nb; const bool more = nxt < nitems;
        if (more) TILE_LOAD(tn, nxt);
#pragma unroll
        for (int i = 0; i < 32; ++i) scr[(2 * i + (lane >> 5)) * 33 + (lane & 31)] = tv[i];
        LDS_WAIT(); asm volatile("" ::: "memory");
        const int c = lane & 7;
#pragma unroll
        for (int j = 0; j < 4; ++j) { const int n = (lane >> 3) + 8 * j; const LAS float* s = scr + (8 * c) * 33 + n;
            u32x4 o; o.x = cvt_pk_bf16(s[0 * 33], s[1 * 33]); o.y = cvt_pk_bf16(s[2 * 33], s[3 * 33]); o.z = cvt_pk_bf16(s[4 * 33], s[5 * 33]); o.w = cvt_pk_bf16(s[6 * 33], s[7 * 33]);
            *(GAS u32x4*)(WT + (size_t)(n0 + n) * K + k0 + 8 * c) = o; }
        LDS_WAIT(); asm volatile("" ::: "memory");
        if (!more) break;
#pragma unroll
        for (int i = 0; i < 32; ++i) tv[i] = tn[i];
        item = nxt;
    }
}
__device__ __forceinline__ void norm_row(const float* xrow, const float* g, bf16* orow, int lane) {
    const GAS f32x4* xr = (const GAS f32x4*)xrow + lane; const GAS f32x4* gr = (const GAS f32x4*)g + lane;
    f32x4 v[16]; float s = 0.f;
#pragma unroll
    for (int j = 0; j < 16; ++j) { v[j] = xr[64 * j]; s += (v[j].x * v[j].x + v[j].y * v[j].y) + (v[j].z * v[j].z + v[j].w * v[j].w); }
    const float rs = 1.0f / sqrtf(wave_sum(s) * (1.f / D) + EPS);
    GAS u32x2* o8 = (GAS u32x2*)orow + lane;
#pragma unroll
    for (int j = 0; j < 16; ++j) { const f32x4 gg = gr[64 * j]; u32x2 w; w.x = cvt_pk_bf16(v[j].x * rs * gg.x, v[j].y * rs * gg.y); w.y = cvt_pk_bf16(v[j].z * rs * gg.z, v[j].w * rs * gg.w); o8[64 * j] = w; }
}
__device__ __forceinline__ void norm_row_q(const float* xrow, const float* g, signed char* orow, float* hscale_m, int lane) {
    const GAS f32x4* xr = (const GAS f32x4*)xrow + lane; const GAS f32x4* gr = (const GAS f32x4*)g + lane;
    f32x4 v[16]; float s = 0.f;
#pragma unroll
    for (int j = 0; j < 16; ++j) { v[j] = xr[64 * j]; s += (v[j].x * v[j].x + v[j].y * v[j].y) + (v[j].z * v[j].z + v[j].w * v[j].w); }
    const float rs = 1.0f / sqrtf(wave_sum(s) * (1.f / D) + EPS); float am = 0.f;
#pragma unroll
    for (int j = 0; j < 16; ++j) { const f32x4 gg = gr[64 * j]; v[j] = v[j] * rs * gg; am = fmaxf(am, fmaxf(fmaxf(fabsf(v[j].x), fabsf(v[j].y)), fmaxf(fabsf(v[j].z), fabsf(v[j].w)))); }
#pragma unroll
    for (int o = 1; o < 64; o <<= 1) am = fmaxf(am, __shfl_xor(am, o));
    const float inv = am > 0.f ? 127.f / am : 0.f; GAS unsigned* o4 = (GAS unsigned*)orow + lane;
#pragma unroll
    for (int j = 0; j < 16; ++j) { const int a = (int)rintf(v[j].x * inv) & 0xff, b = (int)rintf(v[j].y * inv) & 0xff, c = (int)rintf(v[j].z * inv) & 0xff, d = (int)rintf(v[j].w * inv) & 0xff; o4[64 * j] = (unsigned)(a | (b << 8) | (c << 16) | (d << 24)); }
    if (lane == 0) *hscale_m = am * (1.f / 127.f);
}
template <int HMODE, bool XIN32, bool XOUT32> __device__ __forceinline__ void phase_res(LAS unsigned char* lds, const void* xin, const bf16* mx, const float* gpost, void* xout, const float* gnext, bf16* hb, signed char* hq, float* hscale) {
    const int tid = tid_(), lane = tid & 63, gw = bx_() * NWAVES + (tid >> 6), ngw = gdim_() * NWAVES;
    LAS f32x4* gp = (LAS f32x4*)lds; LAS f32x4* gn = (LAS f32x4*)(lds + 16384);
    for (int i = tid; i < D / 4; i += NTHREADS) { gp[i] = ((const GAS f32x4*)gpost)[i]; if (HMODE != 0) gn[i] = ((const GAS f32x4*)gnext)[i]; }
    __syncthreads();
    for (int m = gw; m < M; m += ngw) {
        const GAS u32x2* mr = (const GAS u32x2*)(mx + (size_t)m * D) + lane;
        u32x2 mw[16]; f32x4 v[16];
#pragma unroll
        for (int j = 0; j < 16; ++j) mw[j] = mr[64 * j];
        if constexpr (XIN32) { const GAS f32x4* xr = (const GAS f32x4*)((const float*)xin + (size_t)m * D) + lane;
#pragma unroll
            for (int j = 0; j < 16; ++j) v[j] = xr[64 * j]; }
        else { const GAS u32x2* xr = (const GAS u32x2*)((const bf16*)xin + (size_t)m * D) + lane;
#pragma unroll
            for (int j = 0; j < 16; ++j) { const u32x2 w = xr[64 * j]; v[j] = (f32x4){bf_lo(w.x), bf_hi(w.x), bf_lo(w.y), bf_hi(w.y)}; } }
        float s = 0.f;
#pragma unroll
        for (int j = 0; j < 16; ++j) { const float a = bf_lo(mw[j].x), b = bf_hi(mw[j].x), c = bf_lo(mw[j].y), d = bf_hi(mw[j].y); s += (a * a + b * b) + (c * c + d * d); }
        const float rs = 1.0f / sqrtf(wave_sum(s) * (1.f / D) + EPS);
        float s2 = 0.f;
#pragma unroll
        for (int j = 0; j < 16; ++j) { const f32x4 gg = gp[64 * j + lane]; const f32x4 mm = (f32x4){bf_lo(mw[j].x), bf_hi(mw[j].x), bf_lo(mw[j].y), bf_hi(mw[j].y)};
            v[j] = v[j] + mm * rs * gg;
            if constexpr (XOUT32) { ((GAS f32x4*)((float*)xout + (size_t)m * D) + lane)[64 * j] = v[j]; }
            else { u32x2 w; w.x = cvt_pk_bf16(v[j].x, v[j].y); w.y = cvt_pk_bf16(v[j].z, v[j].w); ((GAS u32x2*)((bf16*)xout + (size_t)m * D) + lane)[64 * j] = w;
                   v[j] = (f32x4){bf_lo(w.x), bf_hi(w.x), bf_lo(w.y), bf_hi(w.y)}; }
            s2 += (v[j].x * v[j].x + v[j].y * v[j].y) + (v[j].z * v[j].z + v[j].w * v[j].w);
            if ((j & 3) == 3) asm volatile("" ::: "memory"); }
        if constexpr (HMODE == 1) {
            const float rs2 = 1.0f / sqrtf(wave_sum(s2) * (1.f / D) + EPS);
            GAS u32x2* o8 = (GAS u32x2*)(hb + (size_t)m * D) + lane;
#pragma unroll
            for (int j = 0; j < 16; ++j) { const f32x4 gg = gn[64 * j + lane]; u32x2 w; w.x = cvt_pk_bf16(v[j].x * rs2 * gg.x, v[j].y * rs2 * gg.y); w.y = cvt_pk_bf16(v[j].z * rs2 * gg.z, v[j].w * rs2 * gg.w); o8[64 * j] = w; if ((j & 3) == 3) asm volatile("" ::: "memory"); }
        }
        if constexpr (HMODE == 2 || HMODE == 3) {
            const float rs2 = 1.0f / sqrtf(wave_sum(s2) * (1.f / D) + EPS); float am = 0.f;
#pragma unroll
            for (int j = 0; j < 16; ++j) { const f32x4 gg = gn[64 * j + lane]; v[j] = v[j] * rs2 * gg;
                if constexpr (HMODE == 3) { u32x2 w; w.x = cvt_pk_bf16(v[j].x, v[j].y); w.y = cvt_pk_bf16(v[j].z, v[j].w); ((GAS u32x2*)(hb + (size_t)m * D) + lane)[64 * j] = w; } am = fmaxf(am, fmaxf(fmaxf(fabsf(v[j].x), fabsf(v[j].y)), fmaxf(fabsf(v[j].z), fabsf(v[j].w)))); if ((j & 3) == 3) asm volatile("" ::: "memory"); }
#pragma unroll
            for (int o = 1; o < 64; o <<= 1) am = fmaxf(am, __shfl_xor(am, o));
            const float inv = am > 0.f ? 127.f / am : 0.f; GAS unsigned* o4 = (GAS unsigned*)(hq + (size_t)m * D) + lane;
#pragma unroll
            for (int j = 0; j < 16; ++j) { const int a = (int)rintf(v[j].x * inv) & 0xff, b = (int)rintf(v[j].y * inv) & 0xff, c = (int)rintf(v[j].z * inv) & 0xff, d = (int)rintf(v[j].w * inv) & 0xff; o4[64 * j] = (unsigned)(a | (b << 8) | (c << 16) | (d << 24)); }
            if (lane == 0) hscale[m] = am * (1.f / 127.f);
        }
    }
    __syncthreads();
}
__device__ __forceinline__ void gate_weights(const float* wga, const float* wgx, bf16* WG) {
    const size_t n = (size_t)NGATE * BWP;
    for (size_t i = (size_t)bx_() * NTHREADS + tid_(); i < n; i += (size_t)gdim_() * NTHREADS) {
        const int jr = (int)(i / BWP), k = (int)(i % BWP); const int nb = jr / 768, jj = jr % 768;
        const int t3 = jj / 256, bj = (jj % 256) / 128, wc = (jj % 128) / 32, gate = (jj % 32) / 16, q = jj % 16; const int ch = 128 * t3 + 64 * bj + 16 * wc + q;
        float v = 0.f; if (k < BW && ch < BW) v = (gate ? wgx : wga)[((size_t)nb * BW + k) * BW + ch];
        WG[i] = (bf16)(cvt_pk_bf16(v, 0.f) & 0xffffu);
    }
}
__device__ __forceinline__ void phase_conv(const bf16* XP, const float* cw, const float* cb, bf16* XB) {
    constexpr int NCH = RWP / 8;
    const int nitems = (M / 16) * NCH;
    for (int it = bx_() * NTHREADS + tid_(); it < nitems; it += gdim_() * NTHREADS) {
        const int ch = it % NCH, tg = it / NCH, m0 = tg * 16, nb = ch / 48, cc0 = (ch % 48) * 8;
        bf16* out = XB + (size_t)m0 * RWP + nb * BWP + cc0;
        if (cc0 >= BW) { for (int r = 0; r < 16; ++r) *(u32x4*)(out + (size_t)r * RWP) = (u32x4){0u, 0u, 0u, 0u}; continue; }
        const int c0 = nb * BW + cc0, t0 = m0 % SEQ;
        float w[4][8], bb[8];
#pragma unroll
        for (int k = 0; k < 4; ++k) { const f32x4 a = *(const f32x4*)(cw + (size_t)k * RW + c0), b = *(const f32x4*)(cw + (size_t)k * RW + c0 + 4);
            w[k][0] = a.x; w[k][1] = a.y; w[k][2] = a.z; w[k][3] = a.w; w[k][4] = b.x; w[k][5] = b.y; w[k][6] = b.z; w[k][7] = b.w; }
        { const f32x4 a = *(const f32x4*)(cb + c0), b = *(const f32x4*)(cb + c0 + 4); bb[0] = a.x; bb[1] = a.y; bb[2] = a.z; bb[3] = a.w; bb[4] = b.x; bb[5] = b.y; bb[6] = b.z; bb[7] = b.w; }
        u32x4 xv[19];
#pragma unroll
        for (int r = 0; r < 19; ++r) xv[r] = (t0 + r - 3 < 0) ? (u32x4){0u, 0u, 0u, 0u} : *(const u32x4*)(XP + (size_t)(m0 + r - 3) * RW + c0);
#pragma unroll
        for (int r = 0; r < 16; ++r) { float y[8];
#pragma unroll
            for (int j = 0; j < 8; ++j) { const int wsel = j >> 1; float x4[4];
#pragma unroll
                for (int k = 0; k < 4; ++k) { const unsigned wd = wsel == 0 ? xv[r + k].x : wsel == 1 ? xv[r + k].y : wsel == 2 ? xv[r + k].z : xv[r + k].w; x4[k] = (j & 1) ? bf_hi(wd) : bf_lo(wd); }
                y[j] = bb[j] + w[0][j] * x4[0] + w[1][j] * x4[1] + w[2][j] * x4[2] + w[3][j] * x4[3]; }
            u32x4 o; o.x = cvt_pk_bf16(y[0], y[1]); o.y = cvt_pk_bf16(y[2], y[3]); o.z = cvt_pk_bf16(y[4], y[5]); o.w = cvt_pk_bf16(y[6], y[7]);
            *(u32x4*)(out + (size_t)r * RWP) = o; }
    }
}
__device__ __forceinline__ void phase_scan1(const bf16* LA, const bf16* INP, float* SUML, float* HEND) {
    constexpr int NC4 = RW / 4; const int nitems = BATCH * NCHUNK * NC4;
    for (int it = bx_() * NTHREADS + tid_(); it < nitems; it += gdim_() * NTHREADS) {
        const int c4 = it % NC4, bc = it / NC4, c = c4 * 4; const size_t m0 = (size_t)bc * CHUNK;
        float sl[4] = {0.f, 0.f, 0.f, 0.f}, h[4] = {0.f, 0.f, 0.f, 0.f};
#pragma unroll 16
        for (int r = 0; r < CHUNK; ++r) { const u32x2 lw = *(const u32x2*)(LA + (m0 + r) * RW + c), iw = *(const u32x2*)(INP + (m0 + r) * RW + c);
            const float l[4] = {bf_lo(lw.x), bf_hi(lw.x), bf_lo(lw.y), bf_hi(lw.y)}, in[4] = {bf_lo(iw.x), bf_hi(iw.x), bf_lo(iw.y), bf_hi(iw.y)};
#pragma unroll
            for (int j = 0; j < 4; ++j) { sl[j] += l[j]; h[j] = ex2(l[j] * LOG2E) * h[j] + in[j]; } }
        *(f32x4*)(SUML + (size_t)bc * RW + c) = (f32x4){sl[0], sl[1], sl[2], sl[3]}; *(f32x4*)(HEND + (size_t)bc * RW + c) = (f32x4){h[0], h[1], h[2], h[3]};
    }
}
__device__ __forceinline__ void phase_scan2(const bf16* LA, const bf16* INP, const float* SUML, const float* HEND, const bf16* G, bf16* Y) {
    constexpr int NC4 = RW / 4; const int nitems = BATCH * NCHUNK * NC4;
    for (int it = bx_() * NTHREADS + tid_(); it < nitems; it += gdim_() * NTHREADS) {
        const int c4 = it % NC4, bc = it / NC4, c = c4 * 4, b = bc / NCHUNK, ci = bc % NCHUNK; const size_t m0 = (size_t)bc * CHUNK;
        float h[4] = {0.f, 0.f, 0.f, 0.f};
#pragma unroll 8
        for (int cj = 0; cj < ci; ++cj) { const f32x4 s = *(const f32x4*)(SUML + (size_t)(b * NCHUNK + cj) * RW + c), e = *(const f32x4*)(HEND + (size_t)(b * NCHUNK + cj) * RW + c);
            h[0] = ex2(s.x * LOG2E) * h[0] + e.x; h[1] = ex2(s.y * LOG2E) * h[1] + e.y; h[2] = ex2(s.z * LOG2E) * h[2] + e.z; h[3] = ex2(s.w * LOG2E) * h[3] + e.w; }
#pragma unroll 16
        for (int r = 0; r < CHUNK; ++r) { const u32x2 lw = *(const u32x2*)(LA + (m0 + r) * RW + c), iw = *(const u32x2*)(INP + (m0 + r) * RW + c), gw = *(const u32x2*)(G + (m0 + r) * RW + c);
            const float l[4] = {bf_lo(lw.x), bf_hi(lw.x), bf_lo(lw.y), bf_hi(lw.y)}, in[4] = {bf_lo(iw.x), bf_hi(iw.x), bf_lo(iw.y), bf_hi(iw.y)}, gg[4] = {bf_lo(gw.x), bf_hi(gw.x), bf_lo(gw.y), bf_hi(gw.y)};
            float y[4];
#pragma unroll
            for (int j = 0; j < 4; ++j) { h[j] = ex2(l[j] * LOG2E) * h[j] + in[j]; y[j] = h[j] * gg[j]; }
            u32x2 o; o.x = cvt_pk_bf16(y[0], y[1]); o.y = cvt_pk_bf16(y[2], y[3]); *(u32x2*)(Y + (m0 + r) * RW + c) = o; }
    }
}
template <int NJ> __device__ __forceinline__ void colmax_matrix_t(const float* W, int K, int N, unsigned* cmax, int gw, int ngw, int lane, int ldw, int& off) {
    const int ncb = N / (256 * NJ), nitems = (K / 64) * ncb;
    const int first = (gw - off % ngw + ngw) % ngw; off += nitems;
    for (int it = first; it < nitems; it += ngw) { const int kb = it / ncb, nb = it % ncb; const GAS f32x4* p = (const GAS f32x4*)(W + (size_t)kb * 64 * ldw + nb * 256 * NJ) + lane;
        f32x4 mx[NJ];
#pragma unroll
        for (int j = 0; j < NJ; ++j) mx[j] = (f32x4){0.f, 0.f, 0.f, 0.f};
#pragma unroll 8
        for (int r = 0; r < 64; ++r) {
#pragma unroll
            for (int j = 0; j < NJ; ++j) { const f32x4 v = p[(size_t)r * (ldw / 4) + 64 * j]; mx[j].x = fmaxf(mx[j].x, fabsf(v.x)); mx[j].y = fmaxf(mx[j].y, fabsf(v.y)); mx[j].z = fmaxf(mx[j].z, fabsf(v.z)); mx[j].w = fmaxf(mx[j].w, fabsf(v.w)); } }
#pragma unroll
        for (int j = 0; j < NJ; ++j) { unsigned* c = cmax + nb * 256 * NJ + 256 * j + lane * 4;
            atomicMax(c, __float_as_uint(mx[j].x)); atomicMax(c + 1, __float_as_uint(mx[j].y)); atomicMax(c + 2, __float_as_uint(mx[j].z)); atomicMax(c + 3, __float_as_uint(mx[j].w)); } }
}
__device__ __forceinline__ void colmax_matrix(const float* W, int K, int N, unsigned* cmax, int gw, int ngw, int lane, int& off, int ldw = 0) {
    if (ldw == 0) ldw = N;
    if (N % 1024 == 0) colmax_matrix_t<4>(W, K, N, cmax, gw, ngw, lane, ldw, off); else colmax_matrix_t<2>(W, K, N, cmax, gw, ngw, lane, ldw, off);
}
__device__ __forceinline__ void quant_transpose_matrix(const float* W, int K, int N, signed char* WQ, const unsigned* cmax, float* wscale, LAS float* scr, const Deal d, int lane, int* csum = nullptr, int ldw = 0) {
    const int nblk = N / 32, nitems = (K / 64) * nblk; if (ldw == 0) ldw = N;
    int item = (d.wi * d.ngrp + d.g) * QCH; if (item >= nitems) return;
    float tv[32], tn[32]; TILE_LOAD(tv, item);
    unsigned tk = deal_issue(d, lane);
    for (;;) {
        int nxt = item + 1;
        if (nxt % QCH == 0) { nxt = (((int)__builtin_amdgcn_readfirstlane(tk) + d.nw) * d.ngrp + d.g) * QCH; if (nxt < nitems) tk = deal_issue(d, lane); }
        const int kb = item / nblk, nb = item % nblk, k0 = 64 * kb, n0 = 32 * nb; const bool more = nxt < nitems;
        if (more) TILE_LOAD(tn, nxt);
#pragma unroll
        for (int i = 0; i < 32; ++i) scr[(2 * i + (lane >> 5)) * 33 + (lane & 31)] = tv[i];
        LDS_WAIT(); asm volatile("" ::: "memory");
        const int c = lane & 7;
#pragma unroll
        for (int j = 0; j < 4; ++j) { const int n = (lane >> 3) + 8 * j; const LAS float* sp = scr + (8 * c) * 33 + n;
            const float cm = __uint_as_float(cmax[n0 + n]); const float inv = cm > 0.f ? 127.f / cm : 0.f;
            int q[8]; int qs = 0;
#pragma unroll
            for (int e = 0; e < 8; ++e) { float v = rintf(sp[e * 33] * inv); v = fminf(fmaxf(v, -127.f), 127.f); qs += (int)v; q[e] = (int)v & 0xff; }
            if (csum) { qs += __shfl_xor(qs, 1); qs += __shfl_xor(qs, 2); qs += __shfl_xor(qs, 4); if (c == 0) atomicAdd(csum + n0 + n, qs); }
            u32x2 o; o.x = (unsigned)(q[0] | (q[1] << 8) | (q[2] << 16) | (q[3] << 24)); o.y = (unsigned)(q[4] | (q[5] << 8) | (q[6] << 16) | (q[7] << 24));
            *(GAS u32x2*)(WQ + (size_t)(n0 + n) * K + k0 + 8 * c) = o;
            if (kb == 0 && c == 0) wscale[n0 + n] = cm * (1.f / 127.f); }
        LDS_WAIT(); asm volatile("" ::: "memory");
        if (!more) break;
#pragma unroll
        for (int i = 0; i < 32; ++i) tv[i] = tn[i];
        item = nxt;
    }
}
#define DYN_BEGIN(lds_, cnt_, nch_, CUR) { \
    volatile LAS unsigned* dsl_ = (volatile LAS unsigned*)((lds_) + LDS_DYN); const bool dt0_ = tid_() == 0; int ds_ = 0; const unsigned dg_ = (unsigned)gdim_(); \
    unsigned CUR = (unsigned)bx_(); \
    while (CUR < (unsigned)(nch_)) { unsigned dnx_ = 0u; if (dt0_) dnx_ = __hip_atomic_fetch_add((cnt_), 1u, __ATOMIC_RELAXED, __HIP_MEMORY_SCOPE_AGENT) + dg_;
#define DYN_END(CUR) \
        if (dt0_) dsl_[ds_] = dnx_; __syncthreads(); CUR = __builtin_amdgcn_readfirstlane(dsl_[ds_]); ds_ ^= 1; } }
#define DYN_CNT(ws_, id_) ((unsigned*)((ws_) + WS_CTL) + CW_DYN + 64 * (id_))
__device__ __forceinline__ void phase_quant_hidden(LAS unsigned char* lds, unsigned* cnt, const bf16* U, const unsigned* rowmax, signed char* UQ, float* ascale) {
    constexpr int TRIP = NTHREADS * 8, TPC = 2;
    constexpr unsigned NCH = (unsigned)((size_t)M * (FF / 8) / (TRIP * TPC));
    const int tid = tid_();
    DYN_BEGIN(lds, cnt, NCH, cur)
        for (int t = 0; t < TPC; ++t) {
            const size_t it0 = ((size_t)cur * TPC + t) * TRIP + tid;
            u32x4 w[8]; float am[8];
#pragma unroll
            for (int k = 0; k < 8; ++k) { const size_t it = it0 + k * NTHREADS; const int m = (int)(it / (FF / 8)), c8 = (int)(it % (FF / 8));
                w[k] = *(const GAS u32x4*)(U + (size_t)m * FF + c8 * 8); am[k] = __uint_as_float(rowmax[m]); }
#pragma unroll
            for (int k = 0; k < 8; ++k) { const size_t it = it0 + k * NTHREADS; const int m = (int)(it / (FF / 8)), c8 = (int)(it % (FF / 8));
                const float inv = am[k] > 0.f ? 255.f / am[k] : 0.f;
                const float a[8] = {bf_lo(w[k].x), bf_hi(w[k].x), bf_lo(w[k].y), bf_hi(w[k].y), bf_lo(w[k].z), bf_hi(w[k].z), bf_lo(w[k].w), bf_hi(w[k].w)};
                int q[8];
#pragma unroll
                for (int e = 0; e < 8; ++e) { float v = fminf(rintf(a[e] * inv), 255.f); q[e] = ((int)v - 128) & 0xff; }
                u32x2 o; o.x = (unsigned)(q[0] | (q[1] << 8) | (q[2] << 16) | (q[3] << 24)); o.y = (unsigned)(q[4] | (q[5] << 8) | (q[6] << 16) | (q[7] << 24));
                *(GAS u32x2*)(UQ + (size_t)m * FF + c8 * 8) = o;
                if (c8 == 0) ascale[m] = am[k] * (1.f / 255.f); }
        }
    DYN_END(cur)
}
template <int NJ> __device__ __forceinline__ void phase_quant_rows(const bf16* src, signed char* dst, float* scale) {
    const int tid = tid_(), lane = tid & 63, gw = bx_() * NWAVES + (tid >> 6), ngw = gdim_() * NWAVES; constexpr int NC = 256 * NJ;
    for (int m = gw; m < M; m += ngw) {
        const GAS u32x2* sr = (const GAS u32x2*)(src + (size_t)m * NC) + lane; u32x2 w[NJ]; float am = 0.f;
#pragma unroll
        for (int j = 0; j < NJ; ++j) w[j] = sr[64 * j];
#pragma unroll
        for (int j = 0; j < NJ; ++j) am = fmaxf(am, fmaxf(fmaxf(fabsf(bf_lo(w[j].x)), fabsf(bf_hi(w[j].x))), fmaxf(fabsf(bf_lo(w[j].y)), fabsf(bf_hi(w[j].y)))));
#pragma unroll
        for (int o = 1; o < 64; o <<= 1) am = fmaxf(am, __shfl_xor(am, o));
        const float inv = am > 0.f ? 127.f / am : 0.f; GAS unsigned* o4 = (GAS unsigned*)(dst + (size_t)m * NC) + lane;
#pragma unroll
        for (int j = 0; j < NJ; ++j) { const int a = (int)rintf(bf_lo(w[j].x) * inv) & 0xff, b = (int)rintf(bf_hi(w[j].x) * inv) & 0xff, c = (int)rintf(bf_lo(w[j].y) * inv) & 0xff, d = (int)rintf(bf_hi(w[j].y) * inv) & 0xff;
            o4[64 * j] = (unsigned)(a | (b << 8) | (c << 16) | (d << 24)); }
        if (lane == 0) scale[m] = am * (1.f / 127.f);
    }
}
__device__ __forceinline__ void phase_kmean(const bf16* K, bf16* KMH, bf16* KML) {
    const int nitems = BATCH * 16 * (D / 2);
    for (int it = bx_() * NTHREADS + tid_(); it < nitems; it += gdim_() * NTHREADS) {
        const int c2 = it % (D / 2), bj = it / (D / 2), b = bj / 16, j = bj % 16, c = c2 * 2;
        const bf16* p = K + ((size_t)b * SEQ + (size_t)j * 256) * D + c; float s0 = 0.f, s1 = 0.f;
#pragma unroll 32
        for (int r = 0; r < 256; ++r) { const unsigned w = *(const unsigned*)(p + (size_t)r * D); s0 += bf_lo(w); s1 += bf_hi(w); }
        s0 *= (1.f / 256.f); s1 *= (1.f / 256.f);
        const unsigned hw = cvt_pk_bf16(s0, s1); const unsigned lw = cvt_pk_bf16(s0 - bf_lo(hw), s1 - bf_hi(hw));
        const int h = c / HD, d = c % HD; const size_t o = (((size_t)b * NH + h) * 16 + j) * HD + d;
        *(unsigned*)(KMH + o) = hw; *(unsigned*)(KML + o) = lw;
    }
}
namespace att {
constexpr int SHM = 16384;
constexpr int OFF_V = 0, OFF_K = 2 * SHM, OFF_WS = 4 * SHM, OFF_TBL = OFF_WS + 2048, OFF_FLAG = OFF_TBL + 512, OFF_WM = OFF_FLAG + 64, OFF_KM = OFF_WM + 64;
constexpr float SCALE = 0.08838834764831845f;
constexpr float C2 = SCALE * 1.4426950408889634f;
#define KSWZ(row, colB) ((row) * 256 + ((colB) ^ (((row) & 7) << 4)))
__device__ __forceinline__ int v_st(int k, int c) { const int kk = (k & ~0xC) | ((k & 4) << 1) | ((k & 8) >> 1); return ((kk >> 3) * 4 + (c >> 5)) * 512 + ((kk & 7) * 32 + (c & 31)) * 2; }
__device__ __forceinline__ int v_rd_base(int lane) { return ((lane & 3) << 3) | (((lane >> 2) & 3) << 6) | (((lane >> 4) & 1) << 5) | (((lane >> 5) & 1) << 8); }
__device__ __forceinline__ int crow(int r, int hi) { return (r & 3) + 8 * (r >> 2) + 4 * hi; }
#define SBAR() __builtin_amdgcn_sched_barrier(0)

__device__ __forceinline__ void qkt(f32x16& p0, f32x16& p1, LAS const char* Kt, int r32, int hi, const bf16x8* qr) {
    p0 = f32x16{}; p1 = f32x16{};
    LAS const char* kb[4];
#pragma unroll
    for (int dd = 0; dd < 4; ++dd) kb[dd] = Kt + KSWZ(r32, (dd * 16 + hi * 8) * 2);
#pragma unroll
    for (int d0 = 0; d0 < 8; ++d0) { LAS const char* a = kb[d0 & 3] + (d0 >> 2) * 128;
        const bf16x8 b0 = *(LAS const bf16x8*)a, b1 = *(LAS const bf16x8*)(a + 32 * 256);
        p0 = __builtin_amdgcn_mfma_f32_32x32x16_bf16(b0, qr[d0], p0, 0, 0, 0);
        p1 = __builtin_amdgcn_mfma_f32_32x32x16_bf16(b1, qr[d0], p1, 0, 0, 0); }
}
__device__ __forceinline__ void qk32(f32x16& p0, LAS const char* Kt, int r32, int hi, const bf16x8* qr) {
    p0 = f32x16{};
    LAS const char* kb[4];
#pragma unroll
    for (int dd = 0; dd < 4; ++dd) kb[dd] = Kt + KSWZ(r32, (dd * 16 + hi * 8) * 2);
#pragma unroll
    for (int d0 = 0; d0 < 8; ++d0) { const bf16x8 b0 = *(LAS const bf16x8*)(kb[d0 & 3] + (d0 >> 2) * 128); p0 = __builtin_amdgcn_mfma_f32_32x32x16_bf16(b0, qr[d0], p0, 0, 0, 0); }
}
__device__ __forceinline__ void pv_tile(f32x16* o, int vb, bf16x8 pa0, bf16x8 pa1, bf16x8 pa2, bf16x8 pa3) {
#define TRRD(dst, off) asm volatile("ds_read_b64_tr_b16 %0, %1 offset:%2" : "=&v"(dst) : "v"(vb), "i"(off) : "memory")
#define PV_D0(d0) do { s16x4 l0, l1, l2, l3, h0, h1, h2, h3; constexpr int b_ = (d0) * 512; \
        TRRD(l0, b_); TRRD(h0, b_ + 2048); TRRD(l1, b_ + 4096); TRRD(h1, b_ + 6144); TRRD(l2, b_ + 8192); TRRD(h2, b_ + 10240); TRRD(l3, b_ + 12288); TRRD(h3, b_ + 14336); \
        asm volatile("s_waitcnt lgkmcnt(0)" ::: "memory"); SBAR(); \
        o[d0] = __builtin_amdgcn_mfma_f32_32x32x16_bf16(pa0, (bf16x8){l0[0], l0[1], l0[2], l0[3], h0[0], h0[1], h0[2], h0[3]}, o[d0], 0, 0, 0); \
        o[d0] = __builtin_amdgcn_mfma_f32_32x32x16_bf16(pa1, (bf16x8){l1[0], l1[1], l1[2], l1[3], h1[0], h1[1], h1[2], h1[3]}, o[d0], 0, 0, 0); \
        o[d0] = __builtin_amdgcn_mfma_f32_32x32x16_bf16(pa2, (bf16x8){l2[0], l2[1], l2[2], l2[3], h2[0], h2[1], h2[2], h2[3]}, o[d0], 0, 0, 0); \
        o[d0] = __builtin_amdgcn_mfma_f32_32x32x16_bf16(pa3, (bf16x8){l3[0], l3[1], l3[2], l3[3], h3[0], h3[1], h3[2], h3[3]}, o[d0], 0, 0, 0); } while (0)
    PV_D0(0); PV_D0(1); PV_D0(2); PV_D0(3);
#undef PV_D0
#undef TRRD
}
__device__ __forceinline__ void pack_p(const f32x16& p0, const f32x16& p1, bf16x8& pa0, bf16x8& pa1, bf16x8& pa2, bf16x8& pa3) {
#define PK4(P, B_, OUT) do { unsigned a0 = cvt_pk_bf16(P[B_+0], P[B_+1]), a1 = cvt_pk_bf16(P[B_+2], P[B_+3]); \
        unsigned b0 = cvt_pk_bf16(P[B_+4], P[B_+5]), b1 = cvt_pk_bf16(P[B_+6], P[B_+7]); \
        auto r0 = __builtin_amdgcn_permlane32_swap(a0, b0, false, false); auto r1 = __builtin_amdgcn_permlane32_swap(a1, b1, false, false); \
        u32x4 w = {r0[0], r1[0], r0[1], r1[1]}; OUT = *reinterpret_cast<bf16x8*>(&w); } while (0)
    PK4(p0, 0, pa0); PK4(p0, 8, pa1); PK4(p1, 0, pa2); PK4(p1, 8, pa3);
#undef PK4
}
__device__ __forceinline__ void both_halves(float v, float& lo, float& hi_) {
    auto rr = __builtin_amdgcn_permlane32_swap(__float_as_uint(v), __float_as_uint(v), false, false); lo = __uint_as_float(rr[0]); hi_ = __uint_as_float(rr[1]);
}
struct Stage { bf16x8 k0, k1, v0, v1; };
__device__ __forceinline__ void stage_load(Stage& s, const bf16* Kp, const bf16* Vp, size_t row0, int sr, int colsc) {
    s.k0 = *(const bf16x8*)(Kp + (row0 + sr) * D + colsc); s.k1 = *(const bf16x8*)(Kp + (row0 + 32 + sr) * D + colsc);
    s.v0 = *(const bf16x8*)(Vp + (row0 + sr) * D + colsc); s.v1 = *(const bf16x8*)(Vp + (row0 + 32 + sr) * D + colsc);
}
__device__ __forceinline__ void stage_write(const Stage& s, LAS char* lds, int buf, int kws, int vst0, int vst1) {
    *(LAS bf16x8*)(lds + OFF_K + buf * SHM + kws) = s.k0; *(LAS bf16x8*)(lds + OFF_K + buf * SHM + kws + 32 * 256) = s.k1;
    *(LAS bf16x8*)(lds + OFF_V + buf * SHM + vst0) = s.v0; *(LAS bf16x8*)(lds + OFF_V + buf * SHM + vst1) = s.v1;
}
__device__ __forceinline__ void store_o(const f32x16* o, const float* rs, bf16* Ow, int r32, int hi) {
#pragma unroll
    for (int r = 0; r < 16; ++r) { const int orow = crow(r, hi);
#pragma unroll
        for (int d0 = 0; d0 < 4; ++d0) { const float v = o[d0][r] * rs[r]; const float vn = __shfl_xor(v, 1);
            if ((r32 & 1) == 0) *(unsigned*)(Ow + (size_t)orow * D + d0 * 32 + r32) = cvt_pk_bf16(v, vn); } }
}

__device__ __forceinline__ void sb_unit(LAS char* lds, const bf16* Q, const bf16* K, const bf16* V, bf16* O, int b, int h, int qb, unsigned& token) {
    const int tid = tid_(), wid = __builtin_amdgcn_readfirstlane(tid >> 6), lane = tid & 63, r32 = lane & 31, hi = lane >> 5;
    const size_t rowbase = (size_t)b * SEQ; const int q0 = qb * 256, qlo = q0 + wid * 32, t = qlo + r32;
    const int sr = tid >> 4, sc = (tid & 15) * 8, colsc = h * HD + sc, kws = KSWZ(sr, sc * 2), vst0 = v_st(sr, sc), vst1 = v_st(32 + sr, sc);
    volatile LAS unsigned* flag = (volatile LAS unsigned*)(lds + OFF_FLAG);
    bf16x8 qr[8];
#pragma unroll
    for (int d0 = 0; d0 < 8; ++d0) qr[d0] = *(const bf16x8*)(Q + (rowbase + qlo + r32) * D + h * HD + d0 * 16 + hi * 8);
    f32x16 o[4] = {}; float carry = 0.f;
    const int ntiles = q0 / 64 + 4;
    Stage st; stage_load(st, K, V, rowbase + (size_t)(ntiles - 1) * 64, sr, colsc); VM_WAIT(); stage_write(st, lds, 0, kws, vst0, vst1);
    __syncthreads();
    const int vbase = (int)(uintptr_t)(lds + OFF_V) + v_rd_base(lane);
    for (int it = 0; it < ntiles; ++it) {
        const int tile = ntiles - 1 - it, kb = tile * 64, buf = it & 1;
        if (it + 1 < ntiles) stage_load(st, K, V, rowbase + (size_t)(tile - 1) * 64, sr, colsc);
        const bool alive = __any(carry > -150.f);
        if (kb <= qlo + 30 && alive) {
            f32x16 p0, p1; qkt(p0, p1, lds + OFF_K + buf * SHM, r32, hi, qr);
            const int dq = t - kb - 4 * hi;
            float lk0[16], lk1[16];
#pragma unroll
            for (int r = 0; r < 16; ++r) { const int c = (r & 3) + 8 * (r >> 2);
                { const float z = p0[r] * C2, l = lg2(1.f + ex2(-fabsf(z))); const bool ok = c < dq; lk0[r] = ok ? fminf(-z, 0.f) - l : 0.f; p0[r] = ok ? fminf(z, 0.f) - l : -__builtin_inff(); }
                { const float z = p1[r] * C2, l = lg2(1.f + ex2(-fabsf(z))); const bool ok = c + 32 < dq; lk1[r] = ok ? fminf(-z, 0.f) - l : 0.f; p1[r] = ok ? fminf(z, 0.f) - l : -__builtin_inff(); } }
            float ge[8], go[8];
#pragma unroll
            for (int k = 0; k < 4; ++k) { const float g0 = (lk0[4 * k] + lk0[4 * k + 1]) + (lk0[4 * k + 2] + lk0[4 * k + 3]), g1 = (lk1[4 * k] + lk1[4 * k + 1]) + (lk1[4 * k + 2] + lk1[4 * k + 3]);
                both_halves(g0, ge[k], go[k]); both_halves(g1, ge[4 + k], go[4 + k]); }
            float suf[8]; float s = carry;
#pragma unroll
            for (int k = 7; k >= 0; --k) { const float so = s; s += go[k]; const float se = s; s += ge[k]; suf[k] = hi ? so : se; }
            carry = s;
#pragma unroll
            for (int k = 0; k < 4; ++k) {
                { float a = suf[k]; p0[4 * k + 3] = ex2(p0[4 * k + 3] + a); a += lk0[4 * k + 3]; p0[4 * k + 2] = ex2(p0[4 * k + 2] + a); a += lk0[4 * k + 2]; p0[4 * k + 1] = ex2(p0[4 * k + 1] + a); a += lk0[4 * k + 1]; p0[4 * k] = ex2(p0[4 * k] + a); }
                { float a = suf[4 + k]; p1[4 * k + 3] = ex2(p1[4 * k + 3] + a); a += lk1[4 * k + 3]; p1[4 * k + 2] = ex2(p1[4 * k + 2] + a); a += lk1[4 * k + 2]; p1[4 * k + 1] = ex2(p1[4 * k + 1] + a); a += lk1[4 * k + 1]; p1[4 * k] = ex2(p1[4 * k] + a); } }
            bf16x8 pa0, pa1, pa2, pa3; pack_p(p0, p1, pa0, pa1, pa2, pa3);
            pv_tile(o, vbase + buf * SHM, pa0, pa1, pa2, pa3);
        }
        if (it + 1 < ntiles) { VM_WAIT(); stage_write(st, lds, buf ^ 1, kws, vst0, vst1); }
        ++token;
        if (__any(carry > -150.f) && lane == 0) flag[it & 1] = token;
        __syncthreads();
        if (flag[it & 1] != token) break;
    }
    float ones[16];
#pragma unroll
    for (int r = 0; r < 16; ++r) ones[r] = 1.f;
    store_o(o, ones, O + (rowbase + qlo) * D + h * HD, r32, hi);
    __syncthreads();
}

constexpr int MV = 0, MK = 3 * SHM, MWS = 5 * SHM, MTBL = MWS + 2048, MWM = MTBL + 512, MKM = MWM + 64;
__device__ __forceinline__ void stage_write_at(const Stage& s, LAS char* lds, int koff, int voff, int kws, int vst0, int vst1) {
    *(LAS bf16x8*)(lds + koff + kws) = s.k0; *(LAS bf16x8*)(lds + koff + kws + 32 * 256) = s.k1;
    *(LAS bf16x8*)(lds + voff + vst0) = s.v0; *(LAS bf16x8*)(lds + voff + vst1) = s.v1;
}
__device__ __forceinline__ void moba_unit(LAS char* lds, const bf16* Q, const bf16* K, const bf16* V, bf16* O, const bf16* KMH, const bf16* KML, const float* relb, int b, int h, int qb) {
    const int tid = tid_(), wid = __builtin_amdgcn_readfirstlane(tid >> 6), lane = tid & 63, r32 = lane & 31, hi = lane >> 5;
    const size_t rowbase = (size_t)b * SEQ; const int q0 = qb * 256, qlo = q0 + wid * 32, t = qlo + r32;
    const int sr = tid >> 4, sc = (tid & 15) * 8, colsc = h * HD + sc, kws = KSWZ(sr, sc * 2), vst0 = v_st(sr, sc), vst1 = v_st(32 + sr, sc);
    LAS float* tbl = (LAS float*)(lds + MTBL); LAS float* wsf = (LAS float*)(lds + MWS) + wid * 64; LAS float* li_l = wsf; LAS float* al_l = wsf + 32;
    volatile LAS unsigned* wm = (volatile LAS unsigned*)(lds + MWM);
    bf16x8 qr[8];
#pragma unroll
    for (int d0 = 0; d0 < 8; ++d0) qr[d0] = *(const bf16x8*)(Q + (rowbase + qlo + r32) * D + h * HD + d0 * 16 + hi * 8);
    if (tid < 128) { const int d = tid; int bk = d; if (d >= 16) { bk = 16 + (int)(lg2((float)d * (1.f / 16.f)) * (16.f / 3.f)); bk = bk > 31 ? 31 : bk; } tbl[d] = relb[bk * NH + h] * LOG2E; }
    if (tid < 256) { const int row = tid >> 4, ch = tid & 15; *(LAS bf16x8*)(lds + MKM + KSWZ(row, ch * 16)) = *(const bf16x8*)(KMH + (((size_t)b * NH + h) * 16 + row) * HD + ch * 8); }
    else { const int row = (tid - 256) >> 4, ch = tid & 15; *(LAS bf16x8*)(lds + MKM + 8192 + KSWZ(row, ch * 16)) = *(const bf16x8*)(KML + (((size_t)b * NH + h) * 16 + row) * HD + ch * 8); }
    __syncthreads();
    unsigned selmask = 0u;
    if (qb > 0) {
        f32x16 gh, gl; qk32(gh, lds + MKM, r32, hi, qr); qk32(gl, lds + MKM + 8192, r32, hi, qr);
        float g[16];
#pragma unroll
        for (int r = 0; r < 8; ++r) { float a, c; both_halves(gh[r] + gl[r], a, c); const int j0 = (r & 3) + 8 * (r >> 2); g[j0] = a; g[j0 + 4] = c; }
        unsigned key[16];
#pragma unroll
        for (int i = 0; i < 16; ++i) { unsigned sb = __float_as_uint(g[i]); sb = (sb & 0x80000000u) ? ~sb : (sb | 0x80000000u); key[i] = (i < qb) ? ((sb & ~15u) | (unsigned)(15 - i)) : 0u; }
        unsigned m1 = 0u, m2 = 0u, m3 = 0u;
#pragma unroll
        for (int i = 0; i < 16; ++i) m1 = key[i] > m1 ? key[i] : m1;
#pragma unroll
        for (int i = 0; i < 16; ++i) { const unsigned kx = key[i] < m1 ? key[i] : 0u; m2 = kx > m2 ? kx : m2; }
#pragma unroll
        for (int i = 0; i < 16; ++i) { const unsigned kx = key[i] < m2 ? key[i] : 0u; m3 = kx > m3 ? kx : m3; }
#pragma unroll
        for (int j = 0; j < 16; ++j) selmask |= (key[j] != 0u && key[j] >= m3) ? (1u << j) : 0u;
    }
    unsigned wmask = 0u;
#pragma unroll
    for (int j = 0; j < 16; ++j) wmask |= (__any((selmask >> j) & 1u) ? 1u : 0u) << j;
    wmask |= 1u << qb;
    if (lane == 0) wm[wid] = wmask;
    __syncthreads();
    unsigned gmask = 0u;
#pragma unroll
    for (int w = 0; w < 8; ++w) gmask |= wm[w];
    gmask = __builtin_amdgcn_readfirstlane(gmask);
    const int nblk = __builtin_popcount(gmask), ntiles = nblk * 4;
    float m_reg = -1e30f, l_reg = 0.f; f32x16 o[4] = {};
    const float far2 = tbl[127];
    const int vbase = (int)(uintptr_t)(lds + MV) + v_rd_base(lane);
    const bool late = wid >= 4; bool pend = false; int pend_vb = 0; bf16x8 pa0 = {}, pa1 = {}, pa2 = {}, pa3 = {};
    unsigned rem = gmask; int jcur = __builtin_ctz(rem); rem &= rem - 1;
    Stage st; stage_load(st, K, V, rowbase + (size_t)jcur * 256, sr, colsc); VM_WAIT(); stage_write_at(st, lds, MK, MV, kws, vst0, vst1);
    __syncthreads();
    int sub = 0;
    for (int it = 0; it < ntiles; ++it) {
        const int buf = it & 1, j = jcur, kb = j * 256 + sub * 64;
        int jn = j, subn = sub + 1; if (subn == 4) { subn = 0; if (rem) { jn = __builtin_ctz(rem); rem &= rem - 1; } }
        if (it + 1 < ntiles) stage_load(st, K, V, rowbase + (size_t)jn * 256 + subn * 64, sr, colsc);
        const bool act = (j == qb) ? (kb <= qlo + 31) : (((wmask >> j) & 1u) != 0u);
        if (pend) { pv_tile(o, vbase + pend_vb * SHM, pa0, pa1, pa2, pa3); pend = false; }
        if (act) {
            f32x16 p0, p1; qkt(p0, p1, lds + MK + buf * SHM, r32, hi, qr);
            const bool rowsel = (j == qb) || (((selmask >> j) & 1u) != 0u);
            const float NEG = -__builtin_inff();
            const bool near = (j + 1 >= qb);
            if (near) {
                const int dq = t - kb - 4 * hi;
#pragma unroll
                for (int r = 0; r < 16; ++r) { const int c = (r & 3) + 8 * (r >> 2); const int d0 = dq - c, d1 = dq - c - 32;
                    const float b0 = tbl[d0 < 0 ? 0 : (d0 > 127 ? 127 : d0)], b1 = tbl[d1 < 0 ? 0 : (d1 > 127 ? 127 : d1)];
                    p0[r] = (rowsel && d0 >= 0) ? fmaf(p0[r], C2, b0) : NEG; p1[r] = (rowsel && d1 >= 0) ? fmaf(p1[r], C2, b1) : NEG; }
            }
            float pmax = p0[0];
#pragma unroll
            for (int r = 1; r < 16; ++r) pmax = fmaxf(pmax, p0[r]);
#pragma unroll
            for (int r = 0; r < 16; ++r) pmax = fmaxf(pmax, p1[r]);
            { float a, c; both_halves(pmax, a, c); pmax = fmaxf(a, c); }
            float off;
            if (!near) { const float brow = rowsel ? far2 : NEG; pmax = fmaf(pmax, C2, brow); }
            float alpha = 1.f;
            if (!__all(pmax - m_reg <= 11.f)) { const float mn = fmaxf(m_reg, pmax); alpha = ex2(m_reg - mn); m_reg = mn; }
            if (!near) { off = (rowsel ? far2 : NEG) - m_reg;
#pragma unroll
                for (int r = 0; r < 16; ++r) { p0[r] = ex2(fmaf(p0[r], C2, off)); p1[r] = ex2(fmaf(p1[r], C2, off)); } }
            else {
#pragma unroll
                for (int r = 0; r < 16; ++r) { p0[r] = ex2(p0[r] - m_reg); p1[r] = ex2(p1[r] - m_reg); } }
            float ps = 0.f;
#pragma unroll
            for (int r = 0; r < 16; ++r) ps += p0[r] + p1[r];
            { float a, c; both_halves(ps, a, c); ps = a + c; }
            l_reg = l_reg * alpha + ps;
            if (__any(alpha < 1.f)) { if (hi == 0) al_l[r32] = alpha; LDS_WAIT();
#pragma unroll
                for (int d_ = 0; d_ < 4; ++d_)
#pragma unroll
                    for (int r = 0; r < 16; ++r) o[d_][r] *= al_l[crow(r, hi)]; }
            pack_p(p0, p1, pa0, pa1, pa2, pa3);
            if (late) { pend = true; pend_vb = it % 3; } else pv_tile(o, vbase + (it % 3) * SHM, pa0, pa1, pa2, pa3);
        }
        if (it + 1 < ntiles) { VM_WAIT(); stage_write_at(st, lds, MK + (buf ^ 1) * SHM, MV + ((it + 1) % 3) * SHM, kws, vst0, vst1); }
        jcur = jn; sub = subn;
        __syncthreads();
    }
    if (pend) pv_tile(o, vbase + pend_vb * SHM, pa0, pa1, pa2, pa3);
    if (hi == 0) li_l[r32] = l_reg; LDS_WAIT();
    float rli[16];
#pragma unroll
    for (int r = 0; r < 16; ++r) rli[r] = rcpf_(li_l[crow(r, hi)]);
    store_o(o, rli, O + (rowbase + qlo) * D + h * HD, r32, hi);
    __syncthreads();
}
#undef KSWZ
#undef SBAR
}
#ifndef WGM_UP
#define WGM_UP 4
#endif
#ifndef WGM_DN
#define WGM_DN 4
#endif
#ifndef WGM_X
#define WGM_X 4
#endif
#ifndef REP_GEMM
#define REP_GEMM 1
#endif
#ifndef REP_THIN
#define REP_THIN 1
#endif
#ifndef REP_PRO
#define REP_PRO 1
#endif
#ifndef REP_RES
#define REP_RES 1
#endif
#ifndef REP_BAR
#define REP_BAR 1
#endif
#ifndef REP_ATT
#define REP_ATT 1
#endif
struct Args { const float* in[23]; float* out; unsigned char* ws; int ph_lo, ph_hi; };
constexpr int NPHASES = 37;

__global__ void __launch_bounds__(NTHREADS, 2) trunk_fwd(Args args) {
    extern __shared__ __attribute__((aligned(16))) unsigned char lds_raw[];
    LAS unsigned char* lds = (LAS unsigned char*)lds_raw;
    const int G = gridDim.x, bx = blockIdx.x;
    unsigned char* ws = args.ws;
    for (int u = tid_(); u < (LDS_BYTES - LDSCTL_OFF) / 4; u += NTHREADS) ((LAS unsigned*)(lds + LDSCTL_OFF))[u] = 0u;
    __syncthreads();
    const int lo = args.ph_lo, hi = args.ph_hi;
    XcdBarrier bar; bar.bar = (unsigned*)(ws + WS_CTL) + CW_BAR; bar.x = 0; bar.st = nullptr;
    if (hi - lo > 1) bar = xcd_barrier_post((unsigned*)(ws + WS_CTL) + CW_BAR, (volatile LAS unsigned*)(lds + LDSCTL_OFF + 64));
#define INR(k) (lo <= (k) && (k) < hi)
#define IN(k) INR((k) + ((k) >= 1 ? 1 : 0))
#define SEAMR(k) do { if (INR(k) && INR((k) + 1)) xcd_barrier(bar); } while (0)
#define SEAM(k) do { if (IN(k) && IN((k) + 1)) for (int rb_ = 0; rb_ < REP_BAR; ++rb_) xcd_barrier(bar); } while (0)

    const float* x_in = args.in[0]; bf16* xo = (bf16*)(ws + WS_X16);
    bf16* HB = (bf16*)(ws + WS_HB); bf16* MX = (bf16*)(ws + WS_MX); unsigned char* scr = ws + WS_SCR;
    bf16* U = (bf16*)(scr + SCR_U);

    if (IN(0)) for (int rep_ = 0; rep_ < REP_PRO; ++rep_) {
        const int tid = tid_(), lane = tid & 63, wave = __builtin_amdgcn_readfirstlane(tid >> 6), gw = bx * NWAVES + wave, ngw = G * NWAVES;
        LAS float* tscr = (LAS float*)(lds + wave * 16384); int cmoff = 0;
        const int gwp = wave * G + bx;
        for (int j = 0; j < 2; ++j) {
            colmax_matrix(args.in[5] + (size_t)j * D * 2 * RW, D, 2 * RW, (unsigned*)(ws + WS_CTL) + CW_COLMAX_LIN + j * 2 * RW, gwp, ngw, lane, cmoff);
            transpose_matrix(args.in[14] + (size_t)j * RW * D, RW, D, (bf16*)(ws + WS_WLOUT) + (size_t)j * D * RW, tscr, deal_make((unsigned*)(ws + WS_CTL), 2 + j, bx, G, wave), lane);
            gate_weights(args.in[9] + (size_t)j * NBLK * BW * BW, args.in[11] + (size_t)j * NBLK * BW * BW, (bf16*)(ws + WS_WGATE) + (size_t)j * NGATE * BWP);
        }
        colmax_matrix(args.in[16], D, 3 * D, (unsigned*)(ws + WS_CTL) + CW_COLMAX_SQKV, gwp, ngw, lane, cmoff);
        colmax_matrix(args.in[17], D, D, (unsigned*)(ws + WS_CTL) + CW_COLMAX_WO, gwp, ngw, lane, cmoff);
        colmax_matrix(args.in[18], D, 3 * D, (unsigned*)(ws + WS_CTL) + CW_COLMAX_MKV, gwp, ngw, lane, cmoff);
        colmax_matrix(args.in[19], D, D, (unsigned*)(ws + WS_CTL) + CW_COLMAX_WO + D, gwp, ngw, lane, cmoff);
        for (int l = 0; l < DEPTH; ++l) {
            colmax_matrix(args.in[21] + (size_t)l * D * FF, D, FF, (unsigned*)(ws + WS_CTL) + CW_COLMAX + l * FF, gwp, ngw, lane, cmoff);
            colmax_matrix(args.in[22] + (size_t)l * FF * D, FF, D, (unsigned*)(ws + WS_CTL) + CW_COLMAX_DN + l * D, gwp, ngw, lane, cmoff);
        }
        for (int i = bx * NTHREADS + tid; i < 2 * RW; i += G * NTHREADS) { const float lam = args.in[13][i]; ((float*)(ws + WS_SP8))[i] = 8.f * log1pf(expf(-lam)); }
        { const Deal d = deal_make((unsigned*)(ws + WS_CTL), 4, bx, G, wave);
          int m = d.wi * d.ngrp + d.g;
          while (m < M) { const unsigned tk = deal_issue(d, lane);
              norm_row_q(x_in + (size_t)m * D, args.in[1], (signed char*)HB + (size_t)m * D, (float*)(ws + WS_HSCALE) + m, lane);
              m = ((int)__builtin_amdgcn_readfirstlane(tk) + d.nw) * d.ngrp + d.g; } }
    }
    SEAMR(0);
    if (INR(1)) {
        const int tid = tid_(), lane = tid & 63, wave = __builtin_amdgcn_readfirstlane(tid >> 6), gw = bx * NWAVES + wave, ngw = G * NWAVES;
        LAS float* tscr = (LAS float*)(lds + wave * 16384); unsigned* ctl_ = (unsigned*)(ws + WS_CTL);
#define DEAL(site) deal_make(ctl_, site, bx, G, wave)
        quant_transpose_matrix(args.in[17], D, D, (signed char*)(ws + WS_WSO), (const unsigned*)(ws + WS_CTL) + CW_COLMAX_WO, (float*)(ws + WS_WSCALE_WO), tscr, DEAL(20), lane);
        quant_transpose_matrix(args.in[19], D, D, (signed char*)(ws + WS_WMO), (const unsigned*)(ws + WS_CTL) + CW_COLMAX_WO + D, (float*)(ws + WS_WSCALE_WO) + D, tscr, DEAL(21), lane);
        quant_transpose_matrix(args.in[18], D, 3 * D, (signed char*)(ws + WS_WMQKV), (const unsigned*)(ws + WS_CTL) + CW_COLMAX_MKV, (float*)(ws + WS_WSCALE_MKV), tscr, DEAL(22), lane);
        quant_transpose_matrix(args.in[16], D, 3 * D, (signed char*)(ws + WS_WSQKV), (const unsigned*)(ws + WS_CTL) + CW_COLMAX_SQKV, (float*)(ws + WS_WSCALE_SQKV), tscr, DEAL(23), lane);
        for (int j = 0; j < 2; ++j) quant_transpose_matrix(args.in[5] + (size_t)j * D * 2 * RW, D, 2 * RW, (signed char*)(ws + WS_WLIN) + (size_t)j * 2 * RW * D * 2, (const unsigned*)(ws + WS_CTL) + CW_COLMAX_LIN + j * 2 * RW, (float*)(ws + WS_WSCALE_LIN) + j * 2 * RW, tscr, DEAL(24 + j), lane);
        for (int l = 0; l < DEPTH; ++l) quant_transpose_matrix(args.in[22] + (size_t)l * FF * D, FF, D, (signed char*)(ws + WS_WDN) + (size_t)l * D * FF, (const unsigned*)(ws + WS_CTL) + CW_COLMAX_DN + l * D, (float*)(ws + WS_WSCALE_DN) + l * D, tscr, DEAL(26 + l), lane, (int*)(ws + WS_CTL) + CW_CS_DN + l * D);
        for (int l = 0; l < DEPTH; ++l) quant_transpose_matrix(args.in[21] + (size_t)l * D * FF, D, FF, (signed char*)(ws + WS_WUP) + (size_t)l * FF * D, (const unsigned*)(ws + WS_CTL) + CW_COLMAX + l * FF, (float*)(ws + WS_WSCALE) + l * FF, tscr, DEAL(30 + l), lane);
    }
    SEAMR(1);

#define RES_PHASE(XIN_, MX_, GP_, XO_, GN_, HB_) phase_res<1, false, false>(lds, XIN_, MX_, GP_, XO_, GN_, HB_, nullptr, nullptr)
#define RES_PHASE_Q(XIN_, MX_, GP_, XO_, GN_) phase_res<2, false, false>(lds, XIN_, MX_, GP_, XO_, GN_, nullptr, (signed char*)HB, (float*)(ws + WS_HSCALE))
#define GEMM_PHASE(EPI_T, Aptr, Btptr, N_, K_, lda_, ldb_, E_, grp_, akstep_) do { \
        pg8::Gemm g_{(const bf16*)(Aptr), (const bf16*)(Btptr), M, (N_), (K_), (lda_), (ldb_)}; pg8::StaticOrder S_; S_.init(M, (N_), G, bx, (grp_), (akstep_), WGM_X); \
        for (int rep_ = 0; rep_ < REP_GEMM; ++rep_) pg8::gemm_phase<EPI_T, pg8::StaticOrder, true>(lds, g_, S_, E_); } while (0)

#define GEMM_PHASE_I8W(EPI_T, Aptr, Btptr, N_, K2_, E_, W_) do { \
        pg8::Gemm g_{(const bf16*)(Aptr), (const bf16*)(Btptr), M, (N_), (K2_), (K2_), (K2_)}; pg8::StaticOrder S_; S_.init(M, (N_), G, bx, 0, 0, (W_)); \
        for (int rep_ = 0; rep_ < REP_GEMM; ++rep_) pg8::gemm_phase<EPI_T, pg8::StaticOrder, true, true>(lds, g_, S_, E_); } while (0)
#define GEMM_PHASE_I8(EPI_T, Aptr, Btptr, N_, K2_, E_) GEMM_PHASE_I8W(EPI_T, Aptr, Btptr, N_, K2_, E_, WGM_X)
#define UP_PHASE(L) do { pg8::EpiBf16<1> E_{U, FF, nullptr, 0, 0, (const float*)(ws + WS_HSCALE), (const float*)(ws + WS_WSCALE) + (size_t)(L) * FF, nullptr, (unsigned*)(ws + WS_CTL) + CW_ROWMAX + (size_t)(L) * M}; \
        GEMM_PHASE_I8W(pg8::EpiBf16<1>, HB, (signed char*)(ws + WS_WUP) + (size_t)(L) * FF * D, FF, D / 2, E_, WGM_UP); } while (0)
#define DOWN_PHASE(L) do { phase_quant_hidden(lds, DYN_CNT(ws, 0 + (L)), U, (const unsigned*)(ws + WS_CTL) + CW_ROWMAX + (size_t)(L) * M, (signed char*)(scr + SCR_UQ), (float*)(ws + WS_ASCALE)); xcd_barrier(bar); \
        pg8::EpiBf16<0> E_{MX, D, nullptr, 0, 0, (const float*)(ws + WS_ASCALE), (const float*)(ws + WS_WSCALE_DN) + (size_t)(L) * D, (const int*)(ws + WS_CTL) + CW_CS_DN + (size_t)(L) * D, nullptr}; \
        GEMM_PHASE_I8W(pg8::EpiBf16<0>, scr + SCR_UQ, (signed char*)(ws + WS_WDN) + (size_t)(L) * D * FF, D, FF / 2, E_, WGM_DN); } while (0)
#define MLP_PHASES(P, L, XIN, GNEXT, HOUT, QM) do { \
    if (IN(P)) UP_PHASE(L); \
    SEAM(P); \
    if (IN((P) + 1)) DOWN_PHASE(L); \
    SEAM((P) + 1); \
    if (IN((P) + 2)) { if ((QM) == 1) RES_PHASE_Q(XIN, MX, args.in[4] + (size_t)(L) * D, xo, GNEXT); else if ((QM) == 2) phase_res<3, false, false>(lds, XIN, MX, args.in[4] + (size_t)(L) * D, xo, GNEXT, HOUT, (signed char*)(ws + WS_HQ2), (float*)(ws + WS_HSCALE)); else RES_PHASE(XIN, MX, args.in[4] + (size_t)(L) * D, xo, GNEXT, HOUT); } \
    SEAM((P) + 2); } while (0)

#define LRU_PHASES(P, L, J, XIN, XF32) do { \
    bf16* Gb = (bf16*)(scr + SCR_G); bf16* XP = (bf16*)(scr + SCR_XP); bf16* XBp = (bf16*)(scr + SCR_XB); bf16* LAp = (bf16*)(scr + SCR_LA); bf16* INPp = (bf16*)(scr + SCR_INP); bf16* Yp = (bf16*)(scr + SCR_Y); \
    float* SUML = (float*)(scr + SCR_SUML); float* HEND = (float*)(scr + SCR_HEND); \
    if (IN(P)) { pg8::EpiBf16<2> E_{Gb, RW, args.in[6] + (size_t)(J) * 2 * RW, RW, (size_t)(SCR_XP - SCR_G) / 2, (const float*)(ws + WS_HSCALE), (const float*)(ws + WS_WSCALE_LIN) + (size_t)(J) * 2 * RW, nullptr, nullptr}; \
            GEMM_PHASE_I8(pg8::EpiBf16<2>, HB, (signed char*)(ws + WS_WLIN) + (size_t)(J) * 2 * RW * D * 2, 2 * RW, D / 2, E_); } \
    SEAM(P); \
    if (IN((P) + 1)) for (int rep_ = 0; rep_ < REP_THIN; ++rep_) phase_conv(XP, args.in[7] + (size_t)(J) * 4 * RW, args.in[8] + (size_t)(J) * RW, XBp); \
    SEAM((P) + 1); \
    if (IN((P) + 2)) { pg8::EpiGate E_{XBp, LAp, INPp, args.in[10] + (size_t)(J) * RW, args.in[12] + (size_t)(J) * RW, (const float*)(ws + WS_SP8) + (size_t)(J) * RW}; \
        GEMM_PHASE(pg8::EpiGate, XBp, (bf16*)(ws + WS_WGATE) + (size_t)(J) * NGATE * BWP, NGATE, BWP, RWP, BWP, E_, 3, BWP); } \
    SEAM((P) + 2); \
    if (IN((P) + 3)) for (int rep_ = 0; rep_ < REP_THIN; ++rep_) phase_scan1(LAp, INPp, SUML, HEND); \
    SEAM((P) + 3); \
    if (IN((P) + 4)) for (int rep_ = 0; rep_ < REP_THIN; ++rep_) phase_scan2(LAp, INPp, SUML, HEND, Gb, Yp); \
    SEAM((P) + 4); \
    if (IN((P) + 5)) { pg8::EpiBf16<0> E_{MX, D, args.in[15] + (size_t)(J) * D, 0, 0, nullptr, nullptr, nullptr, nullptr}; GEMM_PHASE(pg8::EpiBf16<0>, Yp, (bf16*)(ws + WS_WLOUT) + (size_t)(J) * D * RW, D, RW, RW, RW, E_, 0, 0); } \
    SEAM((P) + 5); \
    if (IN((P) + 6)) phase_res<2, XF32, false>(lds, XIN, MX, args.in[2] + (size_t)(L) * D, xo, args.in[3] + (size_t)(L) * D, nullptr, (signed char*)HB, (float*)(ws + WS_HSCALE)); \
    SEAM((P) + 6); } while (0)

    bf16* Qb = (bf16*)(scr + SCR_Q); bf16* Kb = (bf16*)(scr + SCR_K); bf16* Vb = (bf16*)(scr + SCR_V); bf16* Ob = (bf16*)(scr + SCR_O);

    LRU_PHASES(1, 0, 0, x_in, true);
    MLP_PHASES(8, 0, xo, args.in[1] + (size_t)1 * D, HB, 1);

    if (IN(11)) { pg8::EpiBf16<0> E_{Qb, D, nullptr, D, (size_t)(SCR_K - SCR_Q) / 2, (const float*)(ws + WS_HSCALE), (const float*)(ws + WS_WSCALE_SQKV), nullptr, nullptr}; GEMM_PHASE_I8(pg8::EpiBf16<0>, HB, (signed char*)(ws + WS_WSQKV), 3 * D, D / 2, E_); }
    SEAM(11);
    if (IN(12)) for (int rep_ = 0; rep_ < REP_ATT; ++rep_) {
        if (tid_() == 0) { ((volatile LAS unsigned*)(lds + att::OFF_FLAG))[0] = 0u; ((volatile LAS unsigned*)(lds + att::OFF_FLAG))[1] = 0u; }
        __syncthreads();
        unsigned token = 0u;
        for (int u = bx; u < BATCH * NH * 16; u += G) { const int lu = u >> 3, k = lu >> 4, qb = 15 - (lu & 15), bh = 8 * k + (u & 7);
            att::sb_unit((LAS char*)lds, Qb, Kb, Vb, Ob, bh / NH, bh % NH, qb, token); }
    }
    SEAM(12);
    if (IN(13)) { phase_quant_rows<16>(Ob, (signed char*)(scr + SCR_OQ), (float*)(ws + WS_ASCALE)); xcd_barrier(bar);
        pg8::EpiBf16<0> E_{MX, D, nullptr, 0, 0, (const float*)(ws + WS_ASCALE), (const float*)(ws + WS_WSCALE_WO), nullptr, nullptr}; GEMM_PHASE_I8(pg8::EpiBf16<0>, scr + SCR_OQ, (signed char*)(ws + WS_WSO), D, D / 2, E_); }
    SEAM(13);
    if (IN(14)) RES_PHASE_Q(xo, MX, args.in[2] + (size_t)1 * D, xo, args.in[3] + (size_t)1 * D);
    SEAM(14);
    MLP_PHASES(15, 1, xo, args.in[1] + (size_t)2 * D, HB, 1);

    if (IN(18)) { pg8::EpiBf16<0> E_{Qb, D, nullptr, D, (size_t)(SCR_K - SCR_Q) / 2, (const float*)(ws + WS_HSCALE), (const float*)(ws + WS_WSCALE_MKV), nullptr, nullptr}; GEMM_PHASE_I8(pg8::EpiBf16<0>, HB, (signed char*)(ws + WS_WMQKV), 3 * D, D / 2, E_); }
    SEAM(18);
    if (IN(19)) for (int rep_ = 0; rep_ < REP_THIN; ++rep_) phase_kmean(Kb, (bf16*)(scr + SCR_KMH), (bf16*)(scr + SCR_KML));
    SEAM(19);
    if (IN(20)) for (int rep_ = 0; rep_ < REP_ATT; ++rep_) {
        const bf16* KMH = (const bf16*)(scr + SCR_KMH); const bf16* KML = (const bf16*)(scr + SCR_KML);
        for (int u2 = bx * 2; u2 < BATCH * NH * 16; u2 += G * 2) {
#pragma nounroll
            for (int pass = 0; pass < 2; ++pass) { const int u = u2 >> 1, lu = u >> 3, k = lu >> 3, p = lu & 7, bh = 8 * k + (u & 7);
                att::moba_unit((LAS char*)lds, Qb, Kb, Vb, Ob, KMH, KML, args.in[20], bh / NH, bh % NH, pass ? p : 15 - p); } }
    }
    SEAM(20);
    if (IN(21)) { phase_quant_rows<16>(Ob, (signed char*)(scr + SCR_OQ), (float*)(ws + WS_ASCALE)); xcd_barrier(bar);
        pg8::EpiBf16<0> E_{MX, D, nullptr, 0, 0, (const float*)(ws + WS_ASCALE), (const float*)(ws + WS_WSCALE_WO) + D, nullptr, nullptr}; GEMM_PHASE_I8(pg8::EpiBf16<0>, scr + SCR_OQ, (signed char*)(ws + WS_WMO), D, D / 2, E_); }
    SEAM(21);
    if (IN(22)) RES_PHASE_Q(xo, MX, args.in[2] + (size_t)2 * D, xo, args.in[3] + (size_t)2 * D);
    SEAM(22);
    MLP_PHASES(23, 2, xo, args.in[1] + (size_t)3 * D, HB, 1);

    LRU_PHASES(26, 3, 1, xo, false);
    if (IN(33)) UP_PHASE(3);
    SEAM(33);
    if (IN(34)) DOWN_PHASE(3);
    SEAM(34);
    if (IN(35)) phase_res<0, false, true>(lds, xo, MX, args.in[4] + (size_t)3 * D, args.out, nullptr, nullptr, nullptr, nullptr);
#undef IN
#undef SEAM
}
#ifndef N_LAUNCH_MODE
#define N_LAUNCH_MODE 1
#endif
extern "C" void kernel_launch(void* const* d_in, const int* in_sizes, int n_in, void* d_out, int out_size, void* d_ws, size_t ws_size, hipStream_t stream) {
    static int grid = 0;
    if (grid == 0) {
        if (n_in != 23 || in_sizes[0] != M * D || out_size != M * D || ws_size < WS_END) { fprintf(stderr, "kernel_launch: shape/workspace mismatch (n_in %d, in0 %d, out %d, ws %zu, need %zu)\n", n_in, n_in > 0 ? in_sizes[0] : -1, out_size, ws_size, (size_t)WS_END); grid = -1; return; }
        int dev = 0, cus = 0, per_cu = 0;
        if (hipGetDevice(&dev) != hipSuccess || hipDeviceGetAttribute(&cus, hipDeviceAttributeMultiprocessorCount, dev) != hipSuccess) { grid = -1; return; }
        if (hipFuncSetAttribute((const void*)trunk_fwd, hipFuncAttributeMaxDynamicSharedMemorySize, LDS_BYTES) != hipSuccess) { fprintf(stderr, "kernel_launch: hipFuncSetAttribute failed\n"); grid = -1; return; }
        if (hipOccupancyMaxActiveBlocksPerMultiprocessor(&per_cu, (const void*)trunk_fwd, NTHREADS, LDS_BYTES) != hipSuccess || per_cu < 1) fprintf(stderr, "kernel_launch: occupancy query says %d\n", per_cu);
        (void)hipGetLastError();
        grid = cus;
    }
    if (grid < 0) return;
    (void)hipMemsetAsync((char*)d_ws + WS_CTL, 0, CTL_ZERO_BYTES, stream);
    Args a{};
    for (int i = 0; i < 23; ++i) a.in[i] = (const float*)d_in[i];
    a.out = (float*)d_out; a.ws = (unsigned char*)d_ws;
#if N_LAUNCH_MODE == 1
    a.ph_lo = 0; a.ph_hi = NPHASES;
    hipLaunchKernelGGL(trunk_fwd, dim3(grid), dim3(NTHREADS), LDS_BYTES, stream, a);
#else
    for (int p = 0; p < NPHASES; ++p) { a.ph_lo = p; a.ph_hi = p + 1; hipLaunchKernelGGL(trunk_fwd, dim3(grid), dim3(NTHREADS), LDS_BYTES, stream, a);
#ifdef DEBUG_CHECKS
        debug_checks_after(p, a, stream);
#endif
    }
#ifdef DEBUG_CHECKS
    debug_finish(a, stream);
#endif
#endif
}
```

```cpp
#define N_LAUNCH_MODE 1
#include <hip/hip_runtime.h>
#include <cstdio>
#include <cstdint>

#define LAS __attribute__((address_space(3)))
#define GAS __attribute__((address_space(1)))
typedef unsigned short bf16;
typedef short bf16x8 __attribute__((ext_vector_type(8)));
typedef short s16x4 __attribute__((ext_vector_type(4)));
typedef float f32x2 __attribute__((ext_vector_type(2)));
typedef float f32x4 __attribute__((ext_vector_type(4)));
typedef float f32x16 __attribute__((ext_vector_type(16)));
typedef unsigned u32x2 __attribute__((ext_vector_type(2)));
typedef unsigned u32x4 __attribute__((ext_vector_type(4)));
typedef int i32x4 __attribute__((ext_vector_type(4)));

__device__ __forceinline__ unsigned cvt_pk_bf16(float lo, float hi) { unsigned r; asm volatile("v_cvt_pk_bf16_f32 %0, %1, %2" : "=v"(r) : "v"(lo), "v"(hi)); return r; }
__device__ __forceinline__ float bf_lo(unsigned w) { return __uint_as_float(w << 16); }
__device__ __forceinline__ float bf_hi(unsigned w) { return __uint_as_float(w & 0xffff0000u); }
__device__ __forceinline__ float bf2f(bf16 b) { return __uint_as_float(((unsigned)b) << 16); }
__device__ __forceinline__ float ex2(float x) { return __builtin_amdgcn_exp2f(x); }
__device__ __forceinline__ float lg2(float x) { return __builtin_amdgcn_logf(x); }
__device__ __forceinline__ float rcpf_(float x) { return __builtin_amdgcn_rcpf(x); }
constexpr float LOG2E = 1.4426950408889634f, LN2 = 0.6931471805599453f;
__device__ __forceinline__ float sigmoidf_(float v) { return rcpf_(1.0f + ex2(-v * LOG2E)); }
__device__ __forceinline__ int tid_() { int t = threadIdx.x; asm volatile("" : "+v"(t)); return t; }
__device__ __forceinline__ int bx_() { int b = blockIdx.x; asm volatile("" : "+s"(b)); return b; }
__device__ __forceinline__ int gdim_() { int g = gridDim.x; asm volatile("" : "+s"(g)); return g; }

#ifndef PG8_WGM
#define PG8_WGM 8
#endif
namespace pg8 {
constexpr int BM = 256, BK = 64, HALF = 128, HTB = HALF * BK * 2  , STAGE_BYTES = 8 * HTB, NXCD = 8, WGM = PG8_WGM;
__host__ __device__ __forceinline__ int lds_byte(int r, int c) { const int st = (r >> 4) * 2 + (c >> 5), rr = r & 15, cc = c & 31, ob = rr * 64 + cc * 2; return st * 1024 + (ob ^ (((ob >> 9) & 1) << 5)); }
__host__ __device__ __forceinline__ void stage_rc(int b, int& R, int& C) { const int st = b / 1024, sb = b % 1024, swz = sb ^ (((sb >> 9) & 1) << 5); R = (st >> 1) * 16 + swz / 64; C = (st & 1) * 32 + (swz % 64) / 2; }
__host__ __device__ __forceinline__ int perm32(int rho) { const int n = rho >> 4, i = rho & 15; return 8 * (i >> 2) + 4 * n + (i & 3); }

struct Unit { int pm, pn, ak; };
struct Gemm { const bf16* A; const bf16* Bt; int M, N, K, lda, ldb; };

struct StaticOrder {
    int nM, nN, nwg, G, c, grp;
    int akstep, wgm;
    __host__ __device__ void init(int M, int N, int G_, int c_, int grp_ = 0, int akstep_ = 0, int wgm_ = WGM) { nM = M / BM; nN = N / BM; nwg = nM * nN; G = G_; c = c_; grp = grp_; akstep = akstep_; wgm = wgm_; }
    __host__ __device__ bool next(int i, Unit& u) const {
        const long L = (long)i * G + c; if (L >= nwg) return false;
        int wgid = (int)L; { const int q = nwg / NXCD, r = nwg % NXCD, xcd = wgid % NXCD, off = wgid / NXCD; wgid = (xcd < r ? xcd * (q + 1) : r * (q + 1) + (xcd - r) * q) + off; }
        const int nig = wgm * nN, gid = wgid / nig, fm = gid * wgm, gsz = (nM - fm) < wgm ? (nM - fm) : wgm;
        u.pm = fm + ((wgid % nig) % gsz); u.pn = (wgid % nig) / gsz; u.ak = grp ? (u.pn / grp) * akstep : 0; return true;
    }
    __device__ __forceinline__ void a_ready(const Unit&) const {}
    __device__ __forceinline__ void done(const Unit&) const {}
};

__device__ __forceinline__ float gelu_tanh(float x) {
    const float u = 1.5957691216057308f * (x + 0.044715f * x * x * x);
    return x * rcpf_(1.0f + ex2(-u * LOG2E));
}
__device__ __forceinline__ f32x4 tofloat(const f32x4& v) { return v; }
__device__ __forceinline__ f32x4 tofloat(const i32x4& v) { return __builtin_convertvector(v, f32x4); }
template <int ACT> struct EpiBf16 {
    static constexpr bool PERM = true, AFTER_DRAIN = false;
    bf16* O; int ldc; const float* bias; int split_cols; size_t split_stride;
    const float* rscale; const float* cscale;
    const int* coff;
    unsigned* rowmax;
    static constexpr bool LDS_SCALES = true;
    __device__ __forceinline__ void stage_ptrs(const Unit& u, int tid, const float*& pa, const float*& pb) const {
        if (tid < 256) { pa = rscale + u.pm * BM + tid; pb = coff ? (const float*)(coff + u.pn * BM + tid) : pa; }
        else { pa = cscale + u.pn * BM + tid - 256; pb = bias ? bias + u.pn * BM + tid - 256 : pa; }
    }
    __device__ __forceinline__ bool staged() const { return cscale != nullptr; }
    template <class AV> __device__ __forceinline__ void operator()(const AV (&acc)[2][2][4][2], const Unit& u, int wr, int wc, int fr, int fq, const LAS float* sl) const {
        const int row0 = u.pm * BM + wr * 64 + fr; int colt = u.pn * BM; bf16* base = O; int t = 0;
        if (split_cols) { t = colt / split_cols; base += (size_t)t * split_stride; colt -= t * split_cols; }
        const int col0 = colt + wc * 32 + 8 * fq, lcol0 = wc * 32 + 8 * fq;
        f32x4 bv[2][2];
#pragma unroll
        for (int bj = 0; bj < 2; ++bj)
#pragma unroll
            for (int n = 0; n < 2; ++n) bv[bj][n] = !bias ? (f32x4){0.f, 0.f, 0.f, 0.f} : cscale ? *(const LAS f32x4*)(sl + 768 + lcol0 + bj * HALF + 4 * n) : *(const f32x4*)(bias + u.pn * BM + lcol0 + bj * HALF + 4 * n);
        f32x4 cs[2][2];
        if (cscale) {
#pragma unroll
            for (int bj = 0; bj < 2; ++bj)
#pragma unroll
                for (int n = 0; n < 2; ++n) cs[bj][n] = *(const LAS f32x4*)(sl + 256 + lcol0 + bj * HALF + 4 * n); }
        f32x4 co[2][2];
        if (coff) {
#pragma unroll
            for (int bj = 0; bj < 2; ++bj)
#pragma unroll
                for (int n = 0; n < 2; ++n) { const i32x4 ci = *(const LAS i32x4*)(sl + 512 + lcol0 + bj * HALF + 4 * n); co[bj][n] = __builtin_convertvector(ci, f32x4) * 128.f; } }
#pragma unroll
        for (int ai = 0; ai < 2; ++ai) { float rm4[4];
#pragma unroll
            for (int m = 0; m < 4; ++m) { bf16* rowp = base + (size_t)(row0 + ai * HALF + m * 16) * ldc + col0;
                const float rsc = cscale ? sl[wr * 64 + fr + ai * HALF + m * 16] : 1.f; float rmx = 0.f;
#pragma unroll
                for (int bj = 0; bj < 2; ++bj) { f32x4 v0 = tofloat(acc[ai][bj][m][0]), v1 = tofloat(acc[ai][bj][m][1]);
                    if (coff) { v0 = v0 + co[bj][0]; v1 = v1 + co[bj][1]; }
                    if (cscale) { v0 = v0 * rsc * cs[bj][0]; v1 = v1 * rsc * cs[bj][1]; }
                    v0 = v0 + bv[bj][0]; v1 = v1 + bv[bj][1];
                    if (ACT == 1) {
#pragma unroll
                        for (int j = 0; j < 4; ++j) { const float a = fmaxf(v0[j], 0.f), b = fmaxf(v1[j], 0.f); v0[j] = a * a; v1[j] = b * b; } }
                    if (ACT == 2) { if (t == 0) {
#pragma unroll
                        for (int j = 0; j < 4; ++j) { v0[j] = gelu_tanh(v0[j]); v1[j] = gelu_tanh(v1[j]); } } }
                    u32x4 w; w.x = cvt_pk_bf16(v0[0], v0[1]); w.y = cvt_pk_bf16(v0[2], v0[3]); w.z = cvt_pk_bf16(v1[0], v1[1]); w.w = cvt_pk_bf16(v1[2], v1[3]);
                    *(u32x4*)(rowp + bj * HALF) = w;
                    if (rowmax) rmx = fmaxf(rmx, fmaxf(fmaxf(fmaxf(v0[0], v0[1]), fmaxf(v0[2], v0[3])), fmaxf(fmaxf(v1[0], v1[1]), fmaxf(v1[2], v1[3])))); }
                if (rowmax) { rmx = fmaxf(rmx, __shfl_xor(rmx, 16)); rmx = fmaxf(rmx, __shfl_xor(rmx, 32)); rm4[m] = rmx; } }
            if (rowmax) { const float r = fq == 0 ? rm4[0] : fq == 1 ? rm4[1] : fq == 2 ? rm4[2] : rm4[3]; atomicMax(rowmax + row0 + ai * HALF + fq * 16, __float_as_uint(r)); } }
    }
};
struct EpiGate {
    static constexpr bool PERM = false, AFTER_DRAIN = false;
    const bf16* XB; bf16* LA; bf16* INP; const float* bga; const float* bgx; const float* sp8;
    static constexpr bool LDS_SCALES = false;
    __device__ __forceinline__ void stage_ptrs(const Unit&, int, const float*&, const float*&) const {}
    __device__ __forceinline__ bool staged() const { return false; }
    __device__ __forceinline__ void operator()(const f32x4 (&acc)[2][2][4][2], const Unit& u, int wr, int wc, int fr, int fq, const LAS float*) const {
        const int row0 = u.pm * BM + wr * 64 + fr; const int nb = u.pn / 3, t3 = u.pn - 3 * nb;
#pragma unroll
        for (int bj = 0; bj < 2; ++bj) {
            const int cb = 128 * t3 + 64 * bj + 16 * wc + 4 * fq;
            if (cb < 336) {
                const int c = nb * 336 + cb;
                const f32x4 sp = *(const f32x4*)(sp8 + c); const f32x4 ba = *(const f32x4*)(bga + c) * -LOG2E, bx = *(const f32x4*)(bgx + c) * -LOG2E, sp2 = sp * (-2.f * LOG2E);
#pragma unroll
                for (int ai = 0; ai < 2; ++ai)
#pragma unroll
                    for (int m = 0; m < 4; ++m) { const size_t row = (size_t)(row0 + ai * HALF + m * 16);
                        const u32x2 xw = *(const u32x2*)(XB + row * 6144 + nb * 384 + cb);
                        const float xb[4] = {bf_lo(xw.x), bf_hi(xw.x), bf_lo(xw.y), bf_hi(xw.y)};
                        float la[4], ip[4];
#pragma unroll
                        for (int j = 0; j < 4; ++j) { const float r = rcpf_(1.0f + ex2(fmaf(acc[ai][bj][m][0][j], -LOG2E, ba[j]))), ig = rcpf_(1.0f + ex2(fmaf(acc[ai][bj][m][1][j], -LOG2E, bx[j])));
                            const float l = -r * sp[j]; la[j] = l; const float x2 = 2.f * l;
                            const float om = x2 > -0.002f ? -x2 * (1.f + 0.5f * x2) : 1.f - ex2(r * sp2[j]);
                            ip[j] = __builtin_amdgcn_sqrtf(fmaxf(om, 0.f)) * ig * xb[j]; }
                        u32x2 wl, wi; wl.x = cvt_pk_bf16(la[0], la[1]); wl.y = cvt_pk_bf16(la[2], la[3]); wi.x = cvt_pk_bf16(ip[0], ip[1]); wi.y = cvt_pk_bf16(ip[2], ip[3]);
                        *(u32x2*)(LA + row * 5376 + c) = wl; *(u32x2*)(INP + row * 5376 + c) = wi; }
            }
        }
    }
};

template <bool I8> struct AccT { typedef f32x4 type; };
template <> struct AccT<true> { typedef i32x4 type; };
constexpr int EPI_SL_OFF = 131072 + 4096;
template <class Epi, class Sched, bool ALIGN_EPI = true, bool I8 = false>
__device__ __forceinline__ void gemm_phase(LAS unsigned char* lds, const Gemm g, const Sched& S, const Epi& E) {
    const int tid = tid_(), wid = __builtin_amdgcn_readfirstlane(tid >> 6), lane = tid & 63, wr = wid >> 2, wc = wid & 3, fr = lane & 15, fq = lane >> 4;
    const int K = g.K, nt = K / BK;
    unsigned voffA[2], voffB[2];
#pragma unroll
    for (int i = 0; i < 2; ++i) { int R, C; stage_rc(tid * 16 + i * 8192, R, C); const int Rb = Epi::PERM ? ((R & ~31) + perm32(R & 31)) : R;
        voffA[i] = (unsigned)(R * g.lda + C) * 2u; voffB[i] = (unsigned)(Rb * g.ldb + C) * 2u; }
    const size_t kstep = (size_t)(BK * 2);
    const size_t hA = (size_t)HALF * g.lda * 2, hB = (size_t)HALF * g.ldb * 2;
    const size_t tA = 2 * hA, tB = 2 * hB;
    const unsigned ldsw = (unsigned)wid * 1024u;
    const int aoff = lds_byte(wr * 64 + fr, fq * 8), boff = lds_byte(wc * 32 + fr, fq * 8);
#define PG8_SA(b, h) (((b) * 2 + (h)) * HTB)
#define PG8_SB(b, h) ((4 + (b) * 2 + (h)) * HTB)
#define PG8_STAGE(bufoff, gbase, voff) do { _Pragma("unroll") for (int _i = 0; _i < 2; ++_i) \
        __builtin_amdgcn_global_load_lds((const unsigned*)((const char*)(gbase) + (voff)[_i]), (LAS unsigned*)(lds + (bufoff) + ldsw + _i * 8192), 16, 0, 0); } while (0)
#define PG8_LDA(dst, b, h) do { _Pragma("unroll") for (int m = 0; m < 4; ++m) _Pragma("unroll") for (int k = 0; k < 2; ++k) dst[m][k] = *(const LAS bf16x8*)(lds + PG8_SA(b, h) + aoff + m * 2048 + k * 1024); } while (0)
#define PG8_LDB(dst, b, h) do { _Pragma("unroll") for (int n = 0; n < 2; ++n) _Pragma("unroll") for (int k = 0; k < 2; ++k) dst[n][k] = *(const LAS bf16x8*)(lds + PG8_SB(b, h) + boff + n * 2048 + k * 1024); } while (0)
#define PG8_MMA(ai, bj, At, Bt) do { __builtin_amdgcn_s_setprio(1); _Pragma("unroll") for (int m = 0; m < 4; ++m) _Pragma("unroll") for (int n = 0; n < 2; ++n) _Pragma("unroll") for (int k = 0; k < 2; ++k) \
        { if constexpr (I8) acc[ai][bj][m][n] = __builtin_amdgcn_mfma_i32_16x16x64_i8(__builtin_bit_cast(i32x4, Bt[n][k]), __builtin_bit_cast(i32x4, At[m][k]), acc[ai][bj][m][n], 0, 0, 0); \
          else acc[ai][bj][m][n] = __builtin_amdgcn_mfma_f32_16x16x32_bf16(Bt[n][k], At[m][k], acc[ai][bj][m][n], 0, 0, 0); } __builtin_amdgcn_s_setprio(0); } while (0)
#define PG8_WAIT_V(n) asm volatile("s_waitcnt vmcnt(" #n ")" ::: "memory")
#define PG8_WAIT_L(n) asm volatile("s_waitcnt lgkmcnt(" #n ")" ::: "memory")
#define PG8_BAR __builtin_amdgcn_s_barrier()
#define PG8_SCHED __builtin_amdgcn_sched_barrier(0)
    Unit cur, nxt; int ui = 0;
    if (!S.next(0, cur)) return;
    LAS float* sl = (LAS float*)(lds + EPI_SL_OFF); float sva = 1.f, svb = 0.f;
    typedef typename AccT<I8>::type accv;
    accv acc[2][2][4][2];
#pragma unroll
    for (int a = 0; a < 2; ++a)
#pragma unroll
        for (int b = 0; b < 2; ++b)
#pragma unroll
            for (int m = 0; m < 4; ++m)
#pragma unroll
                for (int n = 0; n < 2; ++n) acc[a][b][m][n] = accv{};
    bf16x8 At[4][2], B0[2][2], B1[2][2];
    const char* cA = (const char*)g.A + (size_t)cur.pm * tA + (size_t)cur.ak * 2; const char* cB = (const char*)g.Bt + (size_t)cur.pn * tB;
    S.a_ready(cur);
    PG8_STAGE(PG8_SB(0, 0), cB, voffB); PG8_STAGE(PG8_SB(0, 1), cB + hB, voffB); PG8_STAGE(PG8_SA(0, 0), cA, voffA); PG8_STAGE(PG8_SA(0, 1), cA + hA, voffA);
    if (wr == 1) PG8_BAR;
    PG8_WAIT_V(2); PG8_BAR;
    PG8_STAGE(PG8_SB(1, 0), cB + kstep, voffB); PG8_STAGE(PG8_SA(1, 0), cA + kstep, voffA); PG8_STAGE(PG8_SB(1, 1), cB + hB + kstep, voffB);
    PG8_WAIT_V(6); PG8_BAR;
    for (;;) {
        const bool has_next = S.next(ui + 1, nxt);
        const char* nA = has_next ? (const char*)g.A + (size_t)nxt.pm * tA + (size_t)nxt.ak * 2 : cA; const char* nB = has_next ? (const char*)g.Bt + (size_t)nxt.pn * tB : cB;
#pragma nounroll
        for (int t = 0; t < nt; t += 2) {
            const bool last = (t == nt - 2);
            if constexpr (Epi::LDS_SCALES) { if (t == 0 && E.staged()) { const float* pa; const float* pb; E.stage_ptrs(cur, tid, pa, pb);
                asm volatile("global_load_dword %0, %2, off\n\tglobal_load_dword %1, %3, off" : "=&v"(sva), "=&v"(svb) : "v"(pa), "v"(pb) : "memory"); } }
            const char* a1 = cA + (size_t)(t + 1) * kstep;
            const char* a2 = last ? nA : cA + (size_t)(t + 2) * kstep; const char* b2 = last ? nB : cB + (size_t)(t + 2) * kstep;
            const char* a3 = a2 + kstep; const char* b3 = b2 + kstep;
            if (last && has_next) S.a_ready(nxt);
            PG8_LDB(B0, 0, 0); PG8_LDB(B1, 0, 1); PG8_SCHED; PG8_LDA(At, 0, 0); PG8_STAGE(PG8_SA(1, 1), a1 + hA, voffA);
            PG8_WAIT_V(8); PG8_WAIT_L(0); PG8_BAR; PG8_MMA(0, 0, At, B0); PG8_MMA(0, 1, At, B1); PG8_BAR; PG8_SCHED;
            PG8_LDA(At, 0, 1); PG8_STAGE(PG8_SB(0, 0), b2, voffB); PG8_STAGE(PG8_SB(0, 1), b2 + hB, voffB); PG8_STAGE(PG8_SA(0, 0), a2, voffA);
            PG8_WAIT_V(8); PG8_WAIT_L(0); PG8_BAR; PG8_MMA(1, 0, At, B0); PG8_MMA(1, 1, At, B1); PG8_BAR; PG8_SCHED;
            PG8_LDB(B0, 1, 0); PG8_LDB(B1, 1, 1); PG8_SCHED; PG8_LDA(At, 1, 0); PG8_STAGE(PG8_SA(0, 1), a2 + hA, voffA);
            PG8_WAIT_V(8); PG8_WAIT_L(0); PG8_BAR; PG8_MMA(0, 0, At, B0); PG8_MMA(0, 1, At, B1); PG8_BAR; PG8_SCHED;
            PG8_LDA(At, 1, 1); PG8_STAGE(PG8_SB(1, 0), b3, voffB); PG8_STAGE(PG8_SB(1, 1), b3 + hB, voffB); PG8_STAGE(PG8_SA(1, 0), a3, voffA);
            PG8_WAIT_V(8); PG8_WAIT_L(0); PG8_BAR; PG8_MMA(1, 0, At, B0); PG8_MMA(1, 1, At, B1); PG8_BAR; PG8_SCHED;
            if constexpr (Epi::LDS_SCALES) { if (t == 0 && E.staged()) { sl[tid] = sva; sl[512 + tid] = svb; } }
        }
        if constexpr (ALIGN_EPI) { if (wr == 0) PG8_BAR; }
        E(acc, cur, wr, wc, fr, fq, sl); S.done(cur);
        if (!has_next) break;
#pragma unroll
        for (int a = 0; a < 2; ++a)
#pragma unroll
            for (int b = 0; b < 2; ++b)
#pragma unroll
                for (int m = 0; m < 4; ++m)
#pragma unroll
                    for (int n = 0; n < 2; ++n) acc[a][b][m][n] = accv{};
        cur = nxt; cA = nA; cB = nB; ++ui;
        if constexpr (ALIGN_EPI) { if (wr == 1) PG8_BAR; }
    }
    PG8_WAIT_V(0);
    if constexpr (!ALIGN_EPI) { if (wr == 0) PG8_BAR; }
    PG8_BAR;
#undef PG8_SA
#undef PG8_SB
#undef PG8_STAGE
#undef PG8_LDA
#undef PG8_LDB
#undef PG8_MMA
#undef PG8_WAIT_V
#undef PG8_WAIT_L
#undef PG8_BAR
#undef PG8_SCHED
}
}
constexpr int BATCH = 4, SEQ = 4096, D = 4096, NH = 32, HD = 128, FF = 16384, DEPTH = 4;
constexpr int M = BATCH * SEQ;
constexpr int RW = 5376, NBLK = 16, BW = 336, BWP = 384, RWP = NBLK * BWP;
constexpr int NGATE = NBLK * 768;
constexpr int CHUNK = 64, NCHUNK = SEQ / CHUNK;
constexpr float EPS = 1e-6f;
constexpr int NWAVES = 8, NTHREADS = 512;

constexpr size_t MiB = 1u << 20;
constexpr size_t WS_CTL = 0, CTL_ZERO_BYTES = 2 * MiB;
constexpr size_t WS_WLIN = 2 * MiB;
constexpr size_t WS_WLOUT = WS_WLIN + 168 * MiB;
constexpr size_t WS_WGATE = WS_WLOUT + 84 * MiB;
constexpr size_t WS_WSQKV = WS_WGATE + 18 * MiB;
constexpr size_t WS_WSO = WS_WSQKV + 96 * MiB;
constexpr size_t WS_WMQKV = WS_WSO + 32 * MiB;
constexpr size_t WS_WMO = WS_WMQKV + 96 * MiB;
constexpr size_t WS_WUP = WS_WMO + 32 * MiB;
constexpr size_t WS_WDN = WS_WUP + 512 * MiB;
constexpr size_t WS_SP8 = WS_WDN + 512 * MiB;
constexpr size_t WS_WSCALE_WO = WS_SP8 + 320 * 1024;
constexpr size_t WS_WSCALE_MKV = WS_SP8 + 128 * 1024;
constexpr size_t WS_WSCALE_SQKV = WS_SP8 + 64 * 1024;
constexpr size_t WS_WSCALE_DN = WS_SP8 + 896 * 1024;
constexpr size_t WS_ASCALE = WS_SP8 + 192 * 1024;
constexpr size_t WS_WSCALE_LIN = WS_SP8 + 768 * 1024;
constexpr size_t WS_HSCALE = WS_SP8 + 256 * 1024, WS_WSCALE = WS_SP8 + 512 * 1024;
constexpr size_t WS_HB = WS_SP8 + 1 * MiB;
constexpr size_t WS_MX = WS_HB + 128 * MiB;
constexpr size_t WS_SCR = WS_MX + 128 * MiB;
constexpr size_t SCR_UQ = 512 * MiB;
constexpr size_t SCR_U = 0;
constexpr size_t SCR_G = 0, SCR_XP = 168 * MiB, SCR_XB = 336 * MiB, SCR_LA = 528 * MiB, SCR_INP = 696 * MiB, SCR_Y = 864 * MiB;
constexpr size_t SCR_SUML = 1032 * MiB, SCR_HEND = 1038 * MiB;
constexpr size_t SCR_Q = 0, SCR_K = 128 * MiB, SCR_V = 256 * MiB, SCR_O = 384 * MiB;
constexpr size_t SCR_OQ = 520 * MiB;
constexpr size_t SCR_KMH = 512 * MiB, SCR_KML = 513 * MiB;
constexpr size_t WS_X16 = WS_SCR + 1044 * MiB;
constexpr size_t WS_HQ2 = WS_X16 + 128 * MiB;
constexpr size_t WS_YQ = WS_HQ2 + 64 * MiB;
constexpr size_t WS_END = WS_YQ + 96 * MiB;

constexpr int CW_BAR = 4096;
constexpr int CW_COLMAX_DN = 122880, CW_CS_DN = 139264, CW_ROWMAX = 155648;
constexpr int CW_COLMAX_WO = 241664;
constexpr int CW_COLMAX_MKV = 262144;
constexpr int CW_COLMAX_SQKV = 221184;
constexpr int CW_COLMAX_LIN = 98304;
constexpr int CW_COLMAX = 32768;
constexpr int CW_DYN = 8192;
constexpr int CW_DEAL = 294912;
constexpr int CW_ERR = 16384;

constexpr int RING_BYTES = 131072;
constexpr int LDSCTL_OFF = RING_BYTES;
constexpr int LDS_DYN = LDSCTL_OFF + 8192;
static_assert(pg8::EPI_SL_OFF == LDSCTL_OFF + 4096, "epilogue scale area");
constexpr int LDS_BYTES = 147456;

#define VM_WAIT() asm volatile("s_waitcnt vmcnt(0)" ::: "memory")
#define LDS_WAIT() asm volatile("s_waitcnt lgkmcnt(0)" ::: "memory")

#define XB_TMO      128
#define XB_XCNT(j)  (256  + 64 * (j))
#define XB_XSUB(j)  (1280 + 64 * (j))
#define XB_XGEN(j)  (2304 + 64 * (j))
#define XB_TOP      3328
#define XB_TOPGEN   3392
#define XCD_BAR_WORDS 3456
#define XB_SPIN_CAP (1u << 18)
__device__ __forceinline__ unsigned xb_ld(unsigned* p)              { return __hip_atomic_load(p, __ATOMIC_RELAXED, __HIP_MEMORY_SCOPE_AGENT); }
__device__ __forceinline__ unsigned xb_add(unsigned* p, unsigned v) { return __hip_atomic_fetch_add(p, v, __ATOMIC_RELAXED, __HIP_MEMORY_SCOPE_AGENT); }
__device__ __forceinline__ unsigned xb_xcc_id() { return (unsigned)__builtin_amdgcn_s_getreg((3 << 11) | 20) & 0xFu; }
#define XB_SPIN(cond, bar) do { unsigned _sp = 0; while (cond) { __builtin_amdgcn_s_sleep(1); \
    if ((++_sp & 255u) == 0u) { if (xb_ld(&(bar)[XB_TMO])) break; if (_sp > XB_SPIN_CAP) { atomicAdd(&(bar)[XB_TMO], 1u); break; } } } } while (0)
struct XcdBarrier { unsigned* bar; unsigned x; volatile LAS unsigned* st; };
__device__ __forceinline__ XcdBarrier xcd_barrier_post(unsigned* bar, volatile LAS unsigned* st) {
    XcdBarrier b; b.bar = bar; b.x = xb_xcc_id(); b.st = st;
    if (threadIdx.x == 0) (void)xb_add(&bar[XB_XCNT(b.x)], 1u);
    return b;
}
__device__ __forceinline__ void xcd_barrier_complete(unsigned* bar, unsigned x, unsigned& nloc, unsigned& nx) {
    const unsigned G = gridDim.x * gridDim.y * gridDim.z;
    unsigned sum, cnt, mine, sp = 0u;
    for (;;) {
        sum = 0u; cnt = 0u; mine = 0u;
#pragma unroll
        for (unsigned j = 0; j < 16; ++j) { const unsigned c = xb_ld(&bar[XB_XCNT(j)]); sum += c; cnt += (c > 0u) ? 1u : 0u; mine = (j == x) ? c : mine; }
        if (sum == G) break;
        __builtin_amdgcn_s_sleep(1);
        if ((++sp & 255u) == 0u) { if (xb_ld(&bar[XB_TMO])) break; if (sp > XB_SPIN_CAP) { atomicAdd(&bar[XB_TMO], 1u); break; } }
    }
    nloc = mine > 0u ? mine : 1u; nx = cnt > 0u ? cnt : 1u;
}
__device__ __forceinline__ void xcd_barrier(const XcdBarrier& b) {
    asm volatile("s_waitcnt vmcnt(0)" ::: "memory");
    __syncthreads();
    if (threadIdx.x == 0) {
        unsigned* bar = b.bar;
        __builtin_amdgcn_s_waitcnt(0);
        unsigned nloc = b.st[0], nx = b.st[1];
        if (nloc == 0u) { xcd_barrier_complete(bar, b.x, nloc, nx); b.st[0] = nloc; b.st[1] = nx; }
        const unsigned old = xb_add(&bar[XB_XSUB(b.x)], 1u);
        const unsigned gen = old / nloc;
        if (old + 1u == (gen + 1u) * nloc) {
            __builtin_amdgcn_fence(__ATOMIC_RELEASE, "agent");
            asm volatile("s_waitcnt vmcnt(0)" ::: "memory");
            const unsigned og = xb_add(&bar[XB_TOP], 1u);
            const unsigned tg = og / nx;
            if (og + 1u == (tg + 1u) * nx) xb_add(&bar[XB_TOPGEN], 1u);
            else XB_SPIN(xb_ld(&bar[XB_TOPGEN]) == tg, bar);
            __builtin_amdgcn_fence(__ATOMIC_ACQUIRE, "agent");
            xb_add(&bar[XB_XGEN(b.x)], 1u);
            asm volatile("s_waitcnt vmcnt(0)" ::: "memory");
        } else {
            XB_SPIN(xb_ld(&bar[XB_XGEN(b.x)]) == gen, bar);
            __builtin_amdgcn_fence(__ATOMIC_ACQUIRE, "agent");
            asm volatile("s_waitcnt vmcnt(0)" ::: "memory");
        }
    }
    __syncthreads();
}

__device__ __forceinline__ float wave_sum(float v) {
#pragma unroll
    for (int o = 1; o < 64; o <<= 1) v += __shfl_xor(v, o);
    return v;
}
struct Deal { unsigned* cnt; int g, ngrp, wi, nw; };
__device__ __forceinline__ Deal deal_make(unsigned* ctl, int site, int bx, int G, int wave) {
    Deal d; d.g = min(bx >> 3, 31); d.ngrp = min((G + 7) >> 3, 32); d.cnt = ctl + CW_DEAL + (site * 32 + d.g) * 16; d.wi = (bx - d.g * 8) * NWAVES + wave; d.nw = (d.g == d.ngrp - 1 ? G - d.g * 8 : 8) * NWAVES; return d;
}
__device__ __forceinline__ unsigned deal_issue(const Deal& d, int lane) { unsigned v = 0u; if (lane == 0) v = __hip_atomic_fetch_add(d.cnt, 1u, __ATOMIC_RELAXED, __HIP_MEMORY_SCOPE_AGENT); return v; }
constexpr int QCH = 4;
#define TILE_LOAD(dst, itm) do { const int kb_ = (itm) / nblk, nb_ = (itm) % nblk; const float* wp_ = W + (size_t)(64 * kb_ + (lane >> 5)) * ldw + 32 * nb_ + (lane & 31); \
        _Pragma("unroll") for (int i_ = 0; i_ < 32; ++i_) dst[i_] = wp_[(size_t)(2 * i_) * ldw]; } while (0)
__device__ __forceinline__ void transpose_matrix(const float* W, int K, int N, bf16* WT, LAS float* scr, const Deal d, int lane, int ldw = 0) {
    const int nblk = N / 32, nitems = (K / 64) * nblk; if (ldw == 0) ldw = N;
    int item = (d.wi * d.ngrp + d.g) * QCH; if (item >= nitems) return;
    float tv[32], tn[32]; TILE_LOAD(tv, item);
    unsigned tk = deal_issue(d, lane);
    for (;;) {
        int nxt = item + 1;
        if (nxt % QCH == 0) { nxt = (((int)__builtin_amdgcn_readfirstlane(tk) + d.nw) * d.ngrp + d.g) * QCH; if (nxt < nitems) tk = deal_issue(d, lane); }
        const int kb = item / nblk, nb = item % nblk, k0 = 64 * kb, n0 = 32 * nb; const bool more = nxt < nitems;
        if (more) TILE_LOAD(tn, nxt);
#pragma unroll
        for (int i = 0; i < 32; ++i) scr[(2 * i + (lane >> 5)) * 33 + (lane & 31)] = tv[i];
        LDS_WAIT(); asm volatile("" ::: "memory");
        const int c = lane & 7;
#pragma unroll
        for (int j = 0; j < 4; ++j) { const int n = (lane >> 3) + 8 * j; const LAS float* s = scr + (8 * c) * 33 + n;
            u32x4 o; o.x = cvt_pk_bf16(s[0 * 33], s[1 * 33]); o.y = cvt_pk_bf16(s[2 * 33], s[3 * 33]); o.z = cvt_pk_bf16(s[4 * 33], s[5 * 33]); o.w = cvt_pk_bf16(s[6 * 33], s[7 * 33]);
            *(GAS u32x4*)(WT + (size_t)(n0 + n) * K + k0 + 8 * c) = o; }
        LDS_WAIT(); asm volatile("" ::: "memory");
        if (!more) break;
#pragma unroll
        for (int i = 0; i < 32; ++i) tv[i] = tn[i];
        item = nxt;
    }
}
__device__ __forceinline__ void norm_row(const float* xrow, const float* g, bf16* orow, int lane) {
    const GAS f32x4* xr = (const GAS f32x4*)xrow + lane; const GAS f32x4* gr = (const GAS f32x4*)g + lane;
    f32x4 v[16]; float s = 0.f;
#pragma unroll
    for (int j = 0; j < 16; ++j) { v[j] = xr[64 * j]; s += (v[j].x * v[j].x + v[j].y * v[j].y) + (v[j].z * v[j].z + v[j].w * v[j].w); }
    const float rs = 1.0f / sqrtf(wave_sum(s) * (1.f / D) + EPS);
    GAS u32x2* o8 = (GAS u32x2*)orow + lane;
#pragma unroll
    for (int j = 0; j < 16; ++j) { const f32x4 gg = gr[64 * j]; u32x2 w; w.x = cvt_pk_bf16(v[j].x * rs * gg.x, v[j].y * rs * gg.y); w.y = cvt_pk_bf16(v[j].z * rs * gg.z, v[j].w * rs * gg.w); o8[64 * j] = w; }
}
__device__ __forceinline__ void norm_row_q(const float* xrow, const float* g, signed char* orow, float* hscale_m, int lane) {
    const GAS f32x4* xr = (const GAS f32x4*)xrow + lane; const GAS f32x4* gr = (const GAS f32x4*)g + lane;
    f32x4 v[16]; float s = 0.f;
#pragma unroll
    for (int j = 0; j < 16; ++j) { v[j] = xr[64 * j]; s += (v[j].x * v[j].x + v[j].y * v[j].y) + (v[j].z * v[j].z + v[j].w * v[j].w); }
    const float rs = 1.0f / sqrtf(wave_sum(s) * (1.f / D) + EPS); float am = 0.f;
#pragma unroll
    for (int j = 0; j < 16; ++j) { const f32x4 gg = gr[64 * j]; v[j] = v[j] * rs * gg; am = fmaxf(am, fmaxf(fmaxf(fabsf(v[j].x), fabsf(v[j].y)), fmaxf(fabsf(v[j].z), fabsf(v[j].w)))); }
#pragma unroll
    for (int o = 1; o < 64; o <<= 1) am = fmaxf(am, __shfl_xor(am, o));
    const float inv = am > 0.f ? 127.f / am : 0.f; GAS unsigned* o4 = (GAS unsigned*)orow + lane;
#pragma unroll
    for (int j = 0; j < 16; ++j) { const int a = (int)rintf(v[j].x * inv) & 0xff, b = (int)rintf(v[j].y * inv) & 0xff, c = (int)rintf(v[j].z * inv) & 0xff, d = (int)rintf(v[j].w * inv) & 0xff; o4[64 * j] = (unsigned)(a | (b << 8) | (c << 16) | (d << 24)); }
    if (lane == 0) *hscale_m = am * (1.f / 127.f);
}
template <int HMODE, bool XIN32, bool XOUT32> __device__ __forceinline__ void phase_res(LAS unsigned char* lds, const void* xin, const bf16* mx, const float* gpost, void* xout, const float* gnext, bf16* hb, signed char* hq, float* hscale) {
    const int tid = tid_(), lane = tid & 63, gw = bx_() * NWAVES + (tid >> 6), ngw = gdim_() * NWAVES;
    LAS f32x4* gp = (LAS f32x4*)lds; LAS f32x4* gn = (LAS f32x4*)(lds + 16384);
    for (int i = tid; i < D / 4; i += NTHREADS) { gp[i] = ((const GAS f32x4*)gpost)[i]; if (HMODE != 0) gn[i] = ((const GAS f32x4*)gnext)[i]; }
    __syncthreads();
    for (int m = gw; m < M; m += ngw) {
        const GAS u32x2* mr = (const GAS u32x2*)(mx + (size_t)m * D) + lane;
        u32x2 mw[16]; f32x4 v[16];
#pragma unroll
        for (int j = 0; j < 16; ++j) mw[j] = mr[64 * j];
        if constexpr (XIN32) { const GAS f32x4* xr = (const GAS f32x4*)((const float*)xin + (size_t)m * D) + lane;
#pragma unroll
            for (int j = 0; j < 16; ++j) v[j] = xr[64 * j]; }
        else { const GAS u32x2* xr = (const GAS u32x2*)((const bf16*)xin + (size_t)m * D) + lane;
#pragma unroll
            for (int j = 0; j < 16; ++j) { const u32x2 w = xr[64 * j]; v[j] = (f32x4){bf_lo(w.x), bf_hi(w.x), bf_lo(w.y), bf_hi(w.y)}; } }
        float s = 0.f;
#pragma unroll
        for (int j = 0; j < 16; ++j) { const float a = bf_lo(mw[j].x), b = bf_hi(mw[j].x), c = bf_lo(mw[j].y), d = bf_hi(mw[j].y); s += (a * a + b * b) + (c * c + d * d); }
        const float rs = 1.0f / sqrtf(wave_sum(s) * (1.f / D) + EPS);
        float s2 = 0.f;
#pragma unroll
        for (int j = 0; j < 16; ++j) { const f32x4 gg = gp[64 * j + lane]; const f32x4 mm = (f32x4){bf_lo(mw[j].x), bf_hi(mw[j].x), bf_lo(mw[j].y), bf_hi(mw[j].y)};
            v[j] = v[j] + mm * rs * gg;
            if constexpr (XOUT32) { ((GAS f32x4*)((float*)xout + (size_t)m * D) + lane)[64 * j] = v[j]; }
            else { u32x2 w; w.x = cvt_pk_bf16(v[j].x, v[j].y); w.y = cvt_pk_bf16(v[j].z, v[j].w); ((GAS u32x2*)((bf16*)xout + (size_t)m * D) + lane)[64 * j] = w;
                   v[j] = (f32x4){bf_lo(w.x), bf_hi(w.x), bf_lo(w.y), bf_hi(w.y)}; }
            s2 += (v[j].x * v[j].x + v[j].y * v[j].y) + (v[j].z * v[j].z + v[j].w * v[j].w);
            if ((j & 3) == 3) asm volatile("" ::: "memory"); }
        if constexpr (HMODE == 1) {
            const float rs2 = 1.0f / sqrtf(wave_sum(s2) * (1.f / D) + EPS);
            GAS u32x2* o8 = (GAS u32x2*)(hb + (size_t)m * D) + lane;
#pragma unroll
            for (int j = 0; j < 16; ++j) { const f32x4 gg = gn[64 * j + lane]; u32x2 w; w.x = cvt_pk_bf16(v[j].x * rs2 * gg.x, v[j].y * rs2 * gg.y); w.y = cvt_pk_bf16(v[j].z * rs2 * gg.z, v[j].w * rs2 * gg.w); o8[64 * j] = w; if ((j & 3) == 3) asm volatile("" ::: "memory"); }
        }
        if constexpr (HMODE == 2 || HMODE == 3) {
            const float rs2 = 1.0f / sqrtf(wave_sum(s2) * (1.f / D) + EPS); float am = 0.f;
#pragma unroll
            for (int j = 0; j < 16; ++j) { const f32x4 gg = gn[64 * j + lane]; v[j] = v[j] * rs2 * gg;
                if constexpr (HMODE == 3) { u32x2 w; w.x = cvt_pk_bf16(v[j].x, v[j].y); w.y = cvt_pk_bf16(v[j].z, v[j].w); ((GAS u32x2*)(hb + (size_t)m * D) + lane)[64 * j] = w; } am = fmaxf(am, fmaxf(fmaxf(fabsf(v[j].x), fabsf(v[j].y)), fmaxf(fabsf(v[j].z), fabsf(v[j].w)))); if ((j & 3) == 3) asm volatile("" ::: "memory"); }
#pragma unroll
            for (int o = 1; o < 64; o <<= 1) am = fmaxf(am, __shfl_xor(am, o));
            const float inv = am > 0.f ? 127.f / am : 0.f; GAS unsigned* o4 = (GAS unsigned*)(hq + (size_t)m * D) + lane;
#pragma unroll
            for (int j = 0; j < 16; ++j) { const int a = (int)rintf(v[j].x * inv) & 0xff, b = (int)rintf(v[j].y * inv) & 0xff, c = (int)rintf(v[j].z * inv) & 0xff, d = (int)rintf(v[j].w * inv) & 0xff; o4[64 * j] = (unsigned)(a | (b << 8) | (c << 16) | (d << 24)); }
            if (lane == 0) hscale[m] = am * (1.f / 127.f);
        }
    }
    __syncthreads();
}
__device__ __forceinline__ void gate_weights(const float* wga, const float* wgx, bf16* WG) {
    const size_t n = (size_t)NGATE * BWP;
    for (size_t i = (size_t)bx_() * NTHREADS + tid_(); i < n; i += (size_t)gdim_() * NTHREADS) {
        const int jr = (int)(i / BWP), k = (int)(i % BWP); const int nb = jr / 768, jj = jr % 768;
        const int t3 = jj / 256, bj = (jj % 256) / 128, wc = (jj % 128) / 32, gate = (jj % 32) / 16, q = jj % 16; const int ch = 128 * t3 + 64 * bj + 16 * wc + q;
        float v = 0.f; if (k < BW && ch < BW) v = (gate ? wgx : wga)[((size_t)nb * BW + k) * BW + ch];
        WG[i] = (bf16)(cvt_pk_bf16(v, 0.f) & 0xffffu);
    }
}
__device__ __forceinline__ void phase_conv(const bf16* XP, const float* cw, const float* cb, bf16* XB) {
    constexpr int NCH = RWP / 8;
    const int nitems = (M / 16) * NCH;
    for (int it = bx_() * NTHREADS + tid_(); it < nitems; it += gdim_() * NTHREADS) {
        const int ch = it % NCH, tg = it / NCH, m0 = tg * 16, nb = ch / 48, cc0 = (ch % 48) * 8;
        bf16* out = XB + (size_t)m0 * RWP + nb * BWP + cc0;
        if (cc0 >= BW) { for (int r = 0; r < 16; ++r) *(u32x4*)(out + (size_t)r * RWP) = (u32x4){0u, 0u, 0u, 0u}; continue; }
        const int c0 = nb * BW + cc0, t0 = m0 % SEQ;
        float w[4][8], bb[8];
#pragma unroll
        for (int k = 0; k < 4; ++k) { const f32x4 a = *(const f32x4*)(cw + (size_t)k * RW + c0), b = *(const f32x4*)(cw + (size_t)k * RW + c0 + 4);
            w[k][0] = a.x; w[k][1] = a.y; w[k][2] = a.z; w[k][3] = a.w; w[k][4] = b.x; w[k][5] = b.y; w[k][6] = b.z; w[k][7] = b.w; }
        { const f32x4 a = *(const f32x4*)(cb + c0), b = *(const f32x4*)(cb + c0 + 4); bb[0] = a.x; bb[1] = a.y; bb[2] = a.z; bb[3] = a.w; bb[4] = b.x; bb[5] = b.y; bb[6] = b.z; bb[7] = b.w; }
        u32x4 xv[19];
#pragma unroll
        for (int r = 0; r < 19; ++r) xv[r] = (t0 + r - 3 < 0) ? (u32x4){0u, 0u, 0u, 0u} : *(const u32x4*)(XP + (size_t)(m0 + r - 3) * RW + c0);
#pragma unroll
        for (int r = 0; r < 16; ++r) { float y[8];
#pragma unroll
            for (int j = 0; j < 8; ++j) { const int wsel = j >> 1; float x4[4];
#pragma unroll
                for (int k = 0; k < 4; ++k) { const unsigned wd = wsel == 0 ? xv[r + k].x : wsel == 1 ? xv[r + k].y : wsel == 2 ? xv[r + k].z : xv[r + k].w; x4[k] = (j & 1) ? bf_hi(wd) : bf_lo(wd); }
                y[j] = bb[j] + w[0][j] * x4[0] + w[1][j] * x4[1] + w[2][j] * x4[2] + w[3][j] * x4[3]; }
            u32x4 o; o.x = cvt_pk_bf16(y[0], y[1]); o.y = cvt_pk_bf16(y[2], y[3]); o.z = cvt_pk_bf16(y[4], y[5]); o.w = cvt_pk_bf16(y[6], y[7]);
            *(u32x4*)(out + (size_t)r * RWP) = o; }
    }
}
__device__ __forceinline__ void phase_scan1(const bf16* LA, const bf16* INP, float* SUML, float* HEND) {
    constexpr int NC4 = RW / 4; const int nitems = BATCH * NCHUNK * NC4;
    for (int it = bx_() * NTHREADS + tid_(); it < nitems; it += gdim_() * NTHREADS) {
        const int c4 = it % NC4, bc = it / NC4, c = c4 * 4; const size_t m0 = (size_t)bc * CHUNK;
        float sl[4] = {0.f, 0.f, 0.f, 0.f}, h[4] = {0.f, 0.f, 0.f, 0.f};
#pragma unroll 16
        for (int r = 0; r < CHUNK; ++r) { const u32x2 lw = *(const u32x2*)(LA + (m0 + r) * RW + c), iw = *(const u32x2*)(INP + (m0 + r) * RW + c);
            const float l[4] = {bf_lo(lw.x), bf_hi(lw.x), bf_lo(lw.y), bf_hi(lw.y)}, in[4] = {bf_lo(iw.x), bf_hi(iw.x), bf_lo(iw.y), bf_hi(iw.y)};
#pragma unroll
            for (int j = 0; j < 4; ++j) { sl[j] += l[j]; h[j] = ex2(l[j] * LOG2E) * h[j] + in[j]; } }
        *(f32x4*)(SUML + (size_t)bc * RW + c) = (f32x4){sl[0], sl[1], sl[2], sl[3]}; *(f32x4*)(HEND + (size_t)bc * RW + c) = (f32x4){h[0], h[1], h[2], h[3]};
    }
}
__device__ __forceinline__ void phase_scan2(const bf16* LA, const bf16* INP, const float* SUML, const float* HEND, const bf16* G, bf16* Y) {
    constexpr int NC4 = RW / 4; const int nitems = BATCH * NCHUNK * NC4;
    for (int it = bx_() * NTHREADS + tid_(); it < nitems; it += gdim_() * NTHREADS) {
        const int c4 = it % NC4, bc = it / NC4, c = c4 * 4, b = bc / NCHUNK, ci = bc % NCHUNK; const size_t m0 = (size_t)bc * CHUNK;
        float h[4] = {0.f, 0.f, 0.f, 0.f};
#pragma unroll 8
        for (int cj = 0; cj < ci; ++cj) { const f32x4 s = *(const f32x4*)(SUML + (size_t)(b * NCHUNK + cj) * RW + c), e = *(const f32x4*)(HEND + (size_t)(b * NCHUNK + cj) * RW + c);
            h[0] = ex2(s.x * LOG2E) * h[0] + e.x; h[1] = ex2(s.y * LOG2E) * h[1] + e.y; h[2] = ex2(s.z * LOG2E) * h[2] + e.z; h[3] = ex2(s.w * LOG2E) * h[3] + e.w; }
#pragma unroll 16
        for (int r = 0; r < CHUNK; ++r) { const u32x2 lw = *(const u32x2*)(LA + (m0 + r) * RW + c), iw = *(const u32x2*)(INP + (m0 + r) * RW + c), gw = *(const u32x2*)(G + (m0 + r) * RW + c);
            const float l[4] = {bf_lo(lw.x), bf_hi(lw.x), bf_lo(lw.y), bf_hi(lw.y)}, in[4] = {bf_lo(iw.x), bf_hi(iw.x), bf_lo(iw.y), bf_hi(iw.y)}, gg[4] = {bf_lo(gw.x), bf_hi(gw.x), bf_lo(gw.y), bf_hi(gw.y)};
            float y[4];
#pragma unroll
            for (int j = 0; j < 4; ++j) { h[j] = ex2(l[j] * LOG2E) * h[j] + in[j]; y[j] = h[j] * gg[j]; }
            u32x2 o; o.x = cvt_pk_bf16(y[0], y[1]); o.y = cvt_pk_bf16(y[2], y[3]); *(u32x2*)(Y + (m0 + r) * RW + c) = o; }
    }
}
template <int NJ> __device__ __forceinline__ void colmax_matrix_t(const float* W, int K, int N, unsigned* cmax, int gw, int ngw, int lane, int ldw, int& off) {
    const int ncb = N / (256 * NJ), nitems = (K / 64) * ncb;
    const int first = (gw - off % ngw + ngw) % ngw; off += nitems;
    for (int it = first; it < nitems; it += ngw) { const int kb = it / ncb, nb = it % ncb; const GAS f32x4* p = (const GAS f32x4*)(W + (size_t)kb * 64 * ldw + nb * 256 * NJ) + lane;
        f32x4 mx[NJ];
#pragma unroll
        for (int j = 0; j < NJ; ++j) mx[j] = (f32x4){0.f, 0.f, 0.f, 0.f};
#pragma unroll 8
        for (int r = 0; r < 64; ++r) {
#pragma unroll
            for (int j = 0; j < NJ; ++j) { const f32x4 v = p[(size_t)r * (ldw / 4) + 64 * j]; mx[j].x = fmaxf(mx[j].x, fabsf(v.x)); mx[j].y = fmaxf(mx[j].y, fabsf(v.y)); mx[j].z = fmaxf(mx[j].z, fabsf(v.z)); mx[j].w = fmaxf(mx[j].w, fabsf(v.w)); } }
#pragma unroll
        for (int j = 0; j < NJ; ++j) { unsigned* c = cmax + nb * 256 * NJ + 256 * j + lane * 4;
            atomicMax(c, __float_as_uint(mx[j].x)); atomicMax(c + 1, __float_as_uint(mx[j].y)); atomicMax(c + 2, __float_as_uint(mx[j].z)); atomicMax(c + 3, __float_as_uint(mx[j].w)); } }
}
__device__ __forceinline__ void colmax_matrix(const float* W, int K, int N, unsigned* cmax, int gw, int ngw, int lane, int& off, int ldw = 0) {
    if (ldw == 0) ldw = N;
    if (N % 1024 == 0) colmax_matrix_t<4>(W, K, N, cmax, gw, ngw, lane, ldw, off); else colmax_matrix_t<2>(W, K, N, cmax, gw, ngw, lane, ldw, off);
}
__device__ __forceinline__ void quant_transpose_matrix(const float* W, int K, int N, signed char* WQ, const unsigned* cmax, float* wscale, LAS float* scr, const Deal d, int lane, int* csum = nullptr, int ldw = 0) {
    const int nblk = N / 32, nitems = (K / 64) * nblk; if (ldw == 0) ldw = N;
    int item = (d.wi * d.ngrp + d.g) * QCH; if (item >= nitems) return;
    float tv[32], tn[32]; TILE_LOAD(tv, item);
    unsigned tk = deal_issue(d, lane);
    for (;;) {
        int nxt = item + 1;
        if (nxt % QCH == 0) { nxt = (((int)__builtin_amdgcn_readfirstlane(tk) + d.nw) * d.ngrp + d.g) * QCH; if (nxt < nitems) tk = deal_issue(d, lane); }
        const int kb = item / nblk, nb = item % nblk, k0 = 64 * kb, n0 = 32 * nb; const bool more = nxt < nitems;
        if (more) TILE_LOAD(tn, nxt);
#pragma unroll
        for (int i = 0; i < 32; ++i) scr[(2 * i + (lane >> 5)) * 33 + (lane & 31)] = tv[i];
        LDS_WAIT(); asm volatile("" ::: "memory");
        const int c = lane & 7;
#pragma unroll
        for (int j = 0; j < 4; ++j) { const int n = (lane >> 3) + 8 * j; const LAS float* sp = scr + (8 * c) * 33 + n;
            const float cm = __uint_as_float(cmax[n0 + n]); const float inv = cm > 0.f ? 127.f / cm : 0.f;
            int q[8]; int qs = 0;
#pragma unroll
            for (int e = 0; e < 8; ++e) { float v = rintf(sp[e * 33] * inv); v = fminf(fmaxf(v, -127.f), 127.f); qs += (int)v; q[e] = (int)v & 0xff; }
            if (csum) { qs += __shfl_xor(qs, 1); qs += __shfl_xor(qs, 2); qs += __shfl_xor(qs, 4); if (c == 0) atomicAdd(csum + n0 + n, qs); }
            u32x2 o; o.x = (unsigned)(q[0] | (q[1] << 8) | (q[2] << 16) | (q[3] << 24)); o.y = (unsigned)(q[4] | (q[5] << 8) | (q[6] << 16) | (q[7] << 24));
            *(GAS u32x2*)(WQ + (size_t)(n0 + n) * K + k0 + 8 * c) = o;
            if (kb == 0 && c == 0) wscale[n0 + n] = cm * (1.f / 127.f); }
        LDS_WAIT(); asm volatile("" ::: "memory");
        if (!more) break;
#pragma unroll
        for (int i = 0; i < 32; ++i) tv[i] = tn[i];
        item = nxt;
    }
}
#define DYN_BEGIN(lds_, cnt_, nch_, CUR) { \
    volatile LAS unsigned* dsl_ = (volatile LAS unsigned*)((lds_) + LDS_DYN); const bool dt0_ = tid_() == 0; int ds_ = 0; const unsigned dg_ = (unsigned)gdim_(); \
    unsigned CUR = (unsigned)bx_(); \
    while (CUR < (unsigned)(nch_)) { unsigned dnx_ = 0u; if (dt0_) dnx_ = __hip_atomic_fetch_add((cnt_), 1u, __ATOMIC_RELAXED, __HIP_MEMORY_SCOPE_AGENT) + dg_;
#define DYN_END(CUR) \
        if (dt0_) dsl_[ds_] = dnx_; __syncthreads(); CUR = __builtin_amdgcn_readfirstlane(dsl_[ds_]); ds_ ^= 1; } }
#define DYN_CNT(ws_, id_) ((unsigned*)((ws_) + WS_CTL) + CW_DYN + 64 * (id_))
__device__ __forceinline__ void phase_quant_hidden(LAS unsigned char* lds, unsigned* cnt, const bf16* U, const unsigned* rowmax, signed char* UQ, float* ascale) {
    constexpr int TRIP = NTHREADS * 8, TPC = 2;
    constexpr unsigned NCH = (unsigned)((size_t)M * (FF / 8) / (TRIP * TPC));
    const int tid = tid_();
    DYN_BEGIN(lds, cnt, NCH, cur)
        for (int t = 0; t < TPC; ++t) {
            const size_t it0 = ((size_t)cur * TPC + t) * TRIP + tid;
            u32x4 w[8]; float am[8];
#pragma unroll
            for (int k = 0; k < 8; ++k) { const size_t it = it0 + k * NTHREADS; const int m = (int)(it / (FF / 8)), c8 = (int)(it % (FF / 8));
                w[k] = *(const GAS u32x4*)(U + (size_t)m * FF + c8 * 8); am[k] = __uint_as_float(rowmax[m]); }
#pragma unroll
            for (int k = 0; k < 8; ++k) { const size_t it = it0 + k * NTHREADS; const int m = (int)(it / (FF / 8)), c8 = (int)(it % (FF / 8));
                const float inv = am[k] > 0.f ? 255.f / am[k] : 0.f;
                const float a[8] = {bf_lo(w[k].x), bf_hi(w[k].x), bf_lo(w[k].y), bf_hi(w[k].y), bf_lo(w[k].z), bf_hi(w[k].z), bf_lo(w[k].w), bf_hi(w[k].w)};
                int q[8];
#pragma unroll
                for (int e = 0; e < 8; ++e) { float v = fminf(rintf(a[e] * inv), 255.f); q[e] = ((int)v - 128) & 0xff; }
                u32x2 o; o.x = (unsigned)(q[0] | (q[1] << 8) | (q[2] << 16) | (q[3] << 24)); o.y = (unsigned)(q[4] | (q[5] << 8) | (q[6] << 16) | (q[7] << 24));
                *(GAS u32x2*)(UQ + (size_t)m * FF + c8 * 8) = o;
                if (c8 == 0) ascale[m] = am[k] * (1.f / 255.f); }
        }
    DYN_END(cur)
}
template <int NJ> __device__ __forceinline__ void phase_quant_rows(const bf16* src, signed char* dst, float* scale) {
    const int tid = tid_(), lane = tid & 63, gw = bx_() * NWAVES + (tid >> 6), ngw = gdim_() * NWAVES; constexpr int NC = 256 * NJ;
    for (int m = gw; m < M; m += ngw) {
        const GAS u32x2* sr = (const GAS u32x2*)(src + (size_t)m * NC) + lane; u32x2 w[NJ]; float am = 0.f;
#pragma unroll
        for (int j = 0; j < NJ; ++j) w[j] = sr[64 * j];
#pragma unroll
        for (int j = 0; j < NJ; ++j) am = fmaxf(am, fmaxf(fmaxf(fabsf(bf_lo(w[j].x)), fabsf(bf_hi(w[j].x))), fmaxf(fabsf(bf_lo(w[j].y)), fabsf(bf_hi(w[j].y)))));
#pragma unroll
        for (int o = 1; o < 64; o <<= 1) am = fmaxf(am, __shfl_xor(am, o));
        const float inv = am > 0.f ? 127.f / am : 0.f; GAS unsigned* o4 = (GAS unsigned*)(dst + (size_t)m * NC) + lane;
#pragma unroll
        for (int j = 0; j < NJ; ++j) { const int a = (int)rintf(bf_lo(w[j].x) * inv) & 0xff, b = (int)rintf(bf_hi(w[j].x) * inv) & 0xff, c = (int)rintf(bf_lo(w[j].y) * inv) & 0xff, d = (int)rintf(bf_hi(w[j].y) * inv) & 0xff;
            o4[64 * j] = (unsigned)(a | (b << 8) | (c << 16) | (d << 24)); }
        if (lane == 0) scale[m] = am * (1.f / 127.f);
    }
}
__device__ __forceinline__ void phase_kmean(const bf16* K, bf16* KMH, bf16* KML) {
    const int nitems = BATCH * 16 * (D / 2);
    for (int it = bx_() * NTHREADS + tid_(); it < nitems; it += gdim_() * NTHREADS) {
        const int c2 = it % (D / 2), bj = it / (D / 2), b = bj / 16, j = bj % 16, c = c2 * 2;
        const bf16* p = K + ((size_t)b * SEQ + (size_t)j * 256) * D + c; float s0 = 0.f, s1 = 0.f;
#pragma unroll 32
        for (int r = 0; r < 256; ++r) { const unsigned w = *(const unsigned*)(p + (size_t)r * D); s0 += bf_lo(w); s1 += bf_hi(w); }
        s0 *= (1.f / 256.f); s1 *= (1.f / 256.f);
        const unsigned hw = cvt_pk_bf16(s0, s1); const unsigned lw = cvt_pk_bf16(s0 - bf_lo(hw), s1 - bf_hi(hw));
        const int h = c / HD, d = c % HD; const size_t o = (((size_t)b * NH + h) * 16 + j) * HD + d;
        *(unsigned*)(KMH + o) = hw; *(unsigned*)(KML + o) = lw;
    }
}
namespace att {
constexpr int SHM = 16384;
constexpr int OFF_V = 0, OFF_K = 2 * SHM, OFF_WS = 4 * SHM, OFF_TBL = OFF_WS + 2048, OFF_FLAG = OFF_TBL + 512, OFF_WM = OFF_FLAG + 64, OFF_KM = OFF_WM + 64;
constexpr float SCALE = 0.08838834764831845f;
constexpr float C2 = SCALE * 1.4426950408889634f;
#define KSWZ(row, colB) ((row) * 256 + ((colB) ^ (((row) & 7) << 4)))
__device__ __forceinline__ int v_st(int k, int c) { const int kk = (k & ~0xC) | ((k & 4) << 1) | ((k & 8) >> 1); return ((kk >> 3) * 4 + (c >> 5)) * 512 + ((kk & 7) * 32 + (c & 31)) * 2; }
__device__ __forceinline__ int v_rd_base(int lane) { return ((lane & 3) << 3) | (((lane >> 2) & 3) << 6) | (((lane >> 4) & 1) << 5) | (((lane >> 5) & 1) << 8); }
__device__ __forceinline__ int crow(int r, int hi) { return (r & 3) + 8 * (r >> 2) + 4 * hi; }
#define SBAR() __builtin_amdgcn_sched_barrier(0)

__device__ __forceinline__ void qkt(f32x16& p0, f32x16& p1, LAS const char* Kt, int r32, int hi, const bf16x8* qr) {
    p0 = f32x16{}; p1 = f32x16{};
    LAS const char* kb[4];
#pragma unroll
    for (int dd = 0; dd < 4; ++dd) kb[dd] = Kt + KSWZ(r32, (dd * 16 + hi * 8) * 2);
#pragma unroll
    for (int d0 = 0; d0 < 8; ++d0) { LAS const char* a = kb[d0 & 3] + (d0 >> 2) * 128;
        const bf16x8 b0 = *(LAS const bf16x8*)a, b1 = *(LAS const bf16x8*)(a + 32 * 256);
        p0 = __builtin_amdgcn_mfma_f32_32x32x16_bf16(b0, qr[d0], p0, 0, 0, 0);
        p1 = __builtin_amdgcn_mfma_f32_32x32x16_bf16(b1, qr[d0], p1, 0, 0, 0); }
}
__device__ __forceinline__ void qk32(f32x16& p0, LAS const char* Kt, int r32, int hi, const bf16x8* qr) {
    p0 = f32x16{};
    LAS const char* kb[4];
#pragma unroll
    for (int dd = 0; dd < 4; ++dd) kb[dd] = Kt + KSWZ(r32, (dd * 16 + hi * 8) * 2);
#pragma unroll
    for (int d0 = 0; d0 < 8; ++d0) { const bf16x8 b0 = *(LAS const bf16x8*)(kb[d0 & 3] + (d0 >> 2) * 128); p0 = __builtin_amdgcn_mfma_f32_32x32x16_bf16(b0, qr[d0], p0, 0, 0, 0); }
}
__device__ __forceinline__ void pv_tile(f32x16* o, int vb, bf16x8 pa0, bf16x8 pa1, bf16x8 pa2, bf16x8 pa3) {
#define TRRD(dst, off) asm volatile("ds_read_b64_tr_b16 %0, %1 offset:%2" : "=&v"(dst) : "v"(vb), "i"(off) : "memory")
#define PV_D0(d0) do { s16x4 l0, l1, l2, l3, h0, h1, h2, h3; constexpr int b_ = (d0) * 512; \
        TRRD(l0, b_); TRRD(h0, b_ + 2048); TRRD(l1, b_ + 4096); TRRD(h1, b_ + 6144); TRRD(l2, b_ + 8192); TRRD(h2, b_ + 10240); TRRD(l3, b_ + 12288); TRRD(h3, b_ + 14336); \
        asm volatile("s_waitcnt lgkmcnt(0)" ::: "memory"); SBAR(); \
        o[d0] = __builtin_amdgcn_mfma_f32_32x32x16_bf16(pa0, (bf16x8){l0[0], l0[1], l0[2], l0[3], h0[0], h0[1], h0[2], h0[3]}, o[d0], 0, 0, 0); \
        o[d0] = __builtin_amdgcn_mfma_f32_32x32x16_bf16(pa1, (bf16x8){l1[0], l1[1], l1[2], l1[3], h1[0], h1[1], h1[2], h1[3]}, o[d0], 0, 0, 0); \
        o[d0] = __builtin_amdgcn_mfma_f32_32x32x16_bf16(pa2, (bf16x8){l2[0], l2[1], l2[2], l2[3], h2[0], h2[1], h2[2], h2[3]}, o[d0], 0, 0, 0); \
        o[d0] = __builtin_amdgcn_mfma_f32_32x32x16_bf16(pa3, (bf16x8){l3[0], l3[1], l3[2], l3[3], h3[0], h3[1], h3[2], h3[3]}, o[d0], 0, 0, 0); } while (0)
    PV_D0(0); PV_D0(1); PV_D0(2); PV_D0(3);
#undef PV_D0
#undef TRRD
}
__device__ __forceinline__ void pack_p(const f32x16& p0, const f32x16& p1, bf16x8& pa0, bf16x8& pa1, bf16x8& pa2, bf16x8& pa3) {
#define PK4(P, B_, OUT) do { unsigned a0 = cvt_pk_bf16(P[B_+0], P[B_+1]), a1 = cvt_pk_bf16(P[B_+2], P[B_+3]); \
        unsigned b0 = cvt_pk_bf16(P[B_+4], P[B_+5]), b1 = cvt_pk_bf16(P[B_+6], P[B_+7]); \
        auto r0 = __builtin_amdgcn_permlane32_swap(a0, b0, false, false); auto r1 = __builtin_amdgcn_permlane32_swap(a1, b1, false, false); \
        u32x4 w = {r0[0], r1[0], r0[1], r1[1]}; OUT = *reinterpret_cast<bf16x8*>(&w); } while (0)
    PK4(p0, 0, pa0); PK4(p0, 8, pa1); PK4(p1, 0, pa2); PK4(p1, 8, pa3);
#undef PK4
}
__device__ __forceinline__ void both_halves(float v, float& lo, float& hi_) {
    auto rr = __builtin_amdgcn_permlane32_swap(__float_as_uint(v), __float_as_uint(v), false, false); lo = __uint_as_float(rr[0]); hi_ = __uint_as_float(rr[1]);
}
struct Stage { bf16x8 k0, k1, v0, v1; };
__device__ __forceinline__ void stage_load(Stage& s, const bf16* Kp, const bf16* Vp, size_t row0, int sr, int colsc) {
    s.k0 = *(const bf16x8*)(Kp + (row0 + sr) * D + colsc); s.k1 = *(const bf16x8*)(Kp + (row0 + 32 + sr) * D + colsc);
    s.v0 = *(const bf16x8*)(Vp + (row0 + sr) * D + colsc); s.v1 = *(const bf16x8*)(Vp + (row0 + 32 + sr) * D + colsc);
}
__device__ __forceinline__ void stage_write(const Stage& s, LAS char* lds, int buf, int kws, int vst0, int vst1) {
    *(LAS bf16x8*)(lds + OFF_K + buf * SHM + kws) = s.k0; *(LAS bf16x8*)(lds + OFF_K + buf * SHM + kws + 32 * 256) = s.k1;
    *(LAS bf16x8*)(lds + OFF_V + buf * SHM + vst0) = s.v0; *(LAS bf16x8*)(lds + OFF_V + buf * SHM + vst1) = s.v1;
}
__device__ __forceinline__ void store_o(const f32x16* o, const float* rs, bf16* Ow, int r32, int hi) {
#pragma unroll
    for (int r = 0; r < 16; ++r) { const int orow = crow(r, hi);
#pragma unroll
        for (int d0 = 0; d0 < 4; ++d0) { const float v = o[d0][r] * rs[r]; const float vn = __shfl_xor(v, 1);
            if ((r32 & 1) == 0) *(unsigned*)(Ow + (size_t)orow * D + d0 * 32 + r32) = cvt_pk_bf16(v, vn); } }
}

__device__ __forceinline__ void sb_unit(LAS char* lds, const bf16* Q, const bf16* K, const bf16* V, bf16* O, int b, int h, int qb, unsigned& token) {
    const int tid = tid_(), wid = __builtin_amdgcn_readfirstlane(tid >> 6), lane = tid & 63, r32 = lane & 31, hi = lane >> 5;
    const size_t rowbase = (size_t)b * SEQ; const int q0 = qb * 256, qlo = q0 + wid * 32, t = qlo + r32;
    const int sr = tid >> 4, sc = (tid & 15) * 8, colsc = h * HD + sc, kws = KSWZ(sr, sc * 2), vst0 = v_st(sr, sc), vst1 = v_st(32 + sr, sc);
    volatile LAS unsigned* flag = (volatile LAS unsigned*)(lds + OFF_FLAG);
    bf16x8 qr[8];
#pragma unroll
    for (int d0 = 0; d0 < 8; ++d0) qr[d0] = *(const bf16x8*)(Q + (rowbase + qlo + r32) * D + h * HD + d0 * 16 + hi * 8);
    f32x16 o[4] = {}; float carry = 0.f;
    const int ntiles = q0 / 64 + 4;
    Stage st; stage_load(st, K, V, rowbase + (size_t)(ntiles - 1) * 64, sr, colsc); VM_WAIT(); stage_write(st, lds, 0, kws, vst0, vst1);
    __syncthreads();
    const int vbase = (int)(uintptr_t)(lds + OFF_V) + v_rd_base(lane);
    for (int it = 0; it < ntiles; ++it) {
        const int tile = ntiles - 1 - it, kb = tile * 64, buf = it & 1;
        if (it + 1 < ntiles) stage_load(st, K, V, rowbase + (size_t)(tile - 1) * 64, sr, colsc);
        const bool alive = __any(carry > -150.f);
        if (kb <= qlo + 30 && alive) {
            f32x16 p0, p1; qkt(p0, p1, lds + OFF_K + buf * SHM, r32, hi, qr);
            const int dq = t - kb - 4 * hi;
            float lk0[16], lk1[16];
#pragma unroll
            for (int r = 0; r < 16; ++r) { const int c = (r & 3) + 8 * (r >> 2);
                { const float z = p0[r] * C2, l = lg2(1.f + ex2(-fabsf(z))); const bool ok = c < dq; lk0[r] = ok ? fminf(-z, 0.f) - l : 0.f; p0[r] = ok ? fminf(z, 0.f) - l : -__builtin_inff(); }
                { const float z = p1[r] * C2, l = lg2(1.f + ex2(-fabsf(z))); const bool ok = c + 32 < dq; lk1[r] = ok ? fminf(-z, 0.f) - l : 0.f; p1[r] = ok ? fminf(z, 0.f) - l : -__builtin_inff(); } }
            float ge[8], go[8];
#pragma unroll
            for (int k = 0; k < 4; ++k) { const float g0 = (lk0[4 * k] + lk0[4 * k + 1]) + (lk0[4 * k + 2] + lk0[4 * k + 3]), g1 = (lk1[4 * k] + lk1[4 * k + 1]) + (lk1[4 * k + 2] + lk1[4 * k + 3]);
                both_halves(g0, ge[k], go[k]); both_halves(g1, ge[4 + k], go[4 + k]); }
            float suf[8]; float s = carry;
#pragma unroll
            for (int k = 7; k >= 0; --k) { const float so = s; s += go[k]; const float se = s; s += ge[k]; suf[k] = hi ? so : se; }
            carry = s;
#pragma unroll
            for (int k = 0; k < 4; ++k) {
                { float a = suf[k]; p0[4 * k + 3] = ex2(p0[4 * k + 3] + a); a += lk0[4 * k + 3]; p0[4 * k + 2] = ex2(p0[4 * k + 2] + a); a += lk0[4 * k + 2]; p0[4 * k + 1] = ex2(p0[4 * k + 1] + a); a += lk0[4 * k + 1]; p0[4 * k] = ex2(p0[4 * k] + a); }
                { float a = suf[4 + k]; p1[4 * k + 3] = ex2(p1[4 * k + 3] + a); a += lk1[4 * k + 3]; p1[4 * k + 2] = ex2(p1[4 * k + 2] + a); a += lk1[4 * k + 2]; p1[4 * k + 1] = ex2(p1[4 * k + 1] + a); a += lk1[4 * k + 1]; p1[4 * k] = ex2(p1[4 * k] + a); } }
            bf16x8 pa0, pa1, pa2, pa3; pack_p(p0, p1, pa0, pa1, pa2, pa3);
            pv_tile(o, vbase + buf * SHM, pa0, pa1, pa2, pa3);
        }
        if (it + 1 < ntiles) { VM_WAIT(); stage_write(st, lds, buf ^ 1, kws, vst0, vst1); }
        ++token;
        if (__any(carry > -150.f) && lane == 0) flag[it & 1] = token;
        __syncthreads();
        if (flag[it & 1] != token) break;
    }
    float ones[16];
#pragma unroll
    for (int r = 0; r < 16; ++r) ones[r] = 1.f;
    store_o(o, ones, O + (rowbase + qlo) * D + h * HD, r32, hi);
    __syncthreads();
}

constexpr int MV = 0, MK = 3 * SHM, MWS = 5 * SHM, MTBL = MWS + 2048, MWM = MTBL + 512, MKM = MWM + 64;
__device__ __forceinline__ void stage_write_at(const Stage& s, LAS char* lds, int koff, int voff, int kws, int vst0, int vst1) {
    *(LAS bf16x8*)(lds + koff + kws) = s.k0; *(LAS bf16x8*)(lds + koff + kws + 32 * 256) = s.k1;
    *(LAS bf16x8*)(lds + voff + vst0) = s.v0; *(LAS bf16x8*)(lds + voff + vst1) = s.v1;
}
__device__ __forceinline__ void moba_unit(LAS char* lds, const bf16* Q, const bf16* K, const bf16* V, bf16* O, const bf16* KMH, const bf16* KML, const float* relb, int b, int h, int qb) {
    const int tid = tid_(), wid = __builtin_amdgcn_readfirstlane(tid >> 6), lane = tid & 63, r32 = lane & 31, hi = lane >> 5;
    const size_t rowbase = (size_t)b * SEQ; const int q0 = qb * 256, qlo = q0 + wid * 32, t = qlo + r32;
    const int sr = tid >> 4, sc = (tid & 15) * 8, colsc = h * HD + sc, kws = KSWZ(sr, sc * 2), vst0 = v_st(sr, sc), vst1 = v_st(32 + sr, sc);
    LAS float* tbl = (LAS float*)(lds + MTBL); LAS float* wsf = (LAS float*)(lds + MWS) + wid * 64; LAS float* li_l = wsf; LAS float* al_l = wsf + 32;
    volatile LAS unsigned* wm = (volatile LAS unsigned*)(lds + MWM);
    bf16x8 qr[8];
#pragma unroll
    for (int d0 = 0; d0 < 8; ++d0) qr[d0] = *(const bf16x8*)(Q + (rowbase + qlo + r32) * D + h * HD + d0 * 16 + hi * 8);
    if (tid < 128) { const int d = tid; int bk = d; if (d >= 16) { bk = 16 + (int)(lg2((float)d * (1.f / 16.f)) * (16.f / 3.f)); bk = bk > 31 ? 31 : bk; } tbl[d] = relb[bk * NH + h] * LOG2E; }
    if (tid < 256) { const int row = tid >> 4, ch = tid & 15; *(LAS bf16x8*)(lds + MKM + KSWZ(row, ch * 16)) = *(const bf16x8*)(KMH + (((size_t)b * NH + h) * 16 + row) * HD + ch * 8); }
    else { const int row = (tid - 256) >> 4, ch = tid & 15; *(LAS bf16x8*)(lds + MKM + 8192 + KSWZ(row, ch * 16)) = *(const bf16x8*)(KML + (((size_t)b * NH + h) * 16 + row) * HD + ch * 8); }
    __syncthreads();
    unsigned selmask = 0u;
    if (qb > 0) {
        f32x16 gh, gl; qk32(gh, lds + MKM, r32, hi, qr); qk32(gl, lds + MKM + 8192, r32, hi, qr);
        float g[16];
#pragma unroll
        for (int r = 0; r < 8; ++r) { float a, c; both_halves(gh[r] + gl[r], a, c); const int j0 = (r & 3) + 8 * (r >> 2); g[j0] = a; g[j0 + 4] = c; }
        unsigned key[16];
#pragma unroll
        for (int i = 0; i < 16; ++i) { unsigned sb = __float_as_uint(g[i]); sb = (sb & 0x80000000u) ? ~sb : (sb | 0x80000000u); key[i] = (i < qb) ? ((sb & ~15u) | (unsigned)(15 - i)) : 0u; }
        unsigned m1 = 0u, m2 = 0u, m3 = 0u;
#pragma unroll
        for (int i = 0; i < 16; ++i) m1 = key[i] > m1 ? key[i] : m1;
#pragma unroll
        for (int i = 0; i < 16; ++i) { const unsigned kx = key[i] < m1 ? key[i] : 0u; m2 = kx > m2 ? kx : m2; }
#pragma unroll
        for (int i = 0; i < 16; ++i) { const unsigned kx = key[i] < m2 ? key[i] : 0u; m3 = kx > m3 ? kx : m3; }
#pragma unroll
        for (int j = 0; j < 16; ++j) selmask |= (key[j] != 0u && key[j] >= m3) ? (1u << j) : 0u;
    }
    unsigned wmask = 0u;
#pragma unroll
    for (int j = 0; j < 16; ++j) wmask |= (__any((selmask >> j) & 1u) ? 1u : 0u) << j;
    wmask |= 1u << qb;
    if (lane == 0) wm[wid] = wmask;
    __syncthreads();
    unsigned gmask = 0u;
#pragma unroll
    for (int w = 0; w < 8; ++w) gmask |= wm[w];
    gmask = __builtin_amdgcn_readfirstlane(gmask);
    const int nblk = __builtin_popcount(gmask), ntiles = nblk * 4;
    float m_reg = -1e30f, l_reg = 0.f; f32x16 o[4] = {};
    const float far2 = tbl[127];
    const int vbase = (int)(uintptr_t)(lds + MV) + v_rd_base(lane);
    const bool late = wid >= 4; bool pend = false; int pend_vb = 0; bf16x8 pa0 = {}, pa1 = {}, pa2 = {}, pa3 = {};
    unsigned rem = gmask; int jcur = __builtin_ctz(rem); rem &= rem - 1;
    Stage st; stage_load(st, K, V, rowbase + (size_t)jcur * 256, sr, colsc); VM_WAIT(); stage_write_at(st, lds, MK, MV, kws, vst0, vst1);
    __syncthreads();
    int sub = 0;
    for (int it = 0; it < ntiles; ++it) {
        const int buf = it & 1, j = jcur, kb = j * 256 + sub * 64;
        int jn = j, subn = sub + 1; if (subn == 4) { subn = 0; if (rem) { jn = __builtin_ctz(rem); rem &= rem - 1; } }
        if (it + 1 < ntiles) stage_load(st, K, V, rowbase + (size_t)jn * 256 + subn * 64, sr, colsc);
        const bool act = (j == qb) ? (kb <= qlo + 31) : (((wmask >> j) & 1u) != 0u);
        if (pend) { pv_tile(o, vbase + pend_vb * SHM, pa0, pa1, pa2, pa3); pend = false; }
        if (act) {
            f32x16 p0, p1; qkt(p0, p1, lds + MK + buf * SHM, r32, hi, qr);
            const bool rowsel = (j == qb) || (((selmask >> j) & 1u) != 0u);
            const float NEG = -__builtin_inff();
            const bool near = (j + 1 >= qb);
            if (near) {
                const int dq = t - kb - 4 * hi;
#pragma unroll
                for (int r = 0; r < 16; ++r) { const int c = (r & 3) + 8 * (r >> 2); const int d0 = dq - c, d1 = dq - c - 32;
                    const float b0 = tbl[d0 < 0 ? 0 : (d0 > 127 ? 127 : d0)], b1 = tbl[d1 < 0 ? 0 : (d1 > 127 ? 127 : d1)];
                    p0[r] = (rowsel && d0 >= 0) ? fmaf(p0[r], C2, b0) : NEG; p1[r] = (rowsel && d1 >= 0) ? fmaf(p1[r], C2, b1) : NEG; }
            }
            float pmax = p0[0];
#pragma unroll
            for (int r = 1; r < 16; ++r) pmax = fmaxf(pmax, p0[r]);
#pragma unroll
            for (int r = 0; r < 16; ++r) pmax = fmaxf(pmax, p1[r]);
            { float a, c; both_halves(pmax, a, c); pmax = fmaxf(a, c); }
            float off;
            if (!near) { const float brow = rowsel ? far2 : NEG; pmax = fmaf(pmax, C2, brow); }
            float alpha = 1.f;
            if (!__all(pmax - m_reg <= 11.f)) { const float mn = fmaxf(m_reg, pmax); alpha = ex2(m_reg - mn); m_reg = mn; }
            if (!near) { off = (rowsel ? far2 : NEG) - m_reg;
#pragma unroll
                for (int r = 0; r < 16; ++r) { p0[r] = ex2(fmaf(p0[r], C2, off)); p1[r] = ex2(fmaf(p1[r], C2, off)); } }
            else {
#pragma unroll
                for (int r = 0; r < 16; ++r) { p0[r] = ex2(p0[r] - m_reg); p1[r] = ex2(p1[r] - m_reg); } }
            float ps = 0.f;
#pragma unroll
            for (int r = 0; r < 16; ++r) ps += p0[r] + p1[r];
            { float a, c; both_halves(ps, a, c); ps = a + c; }
            l_reg = l_reg * alpha + ps;
            if (__any(alpha < 1.f)) { if (hi == 0) al_l[r32] = alpha; LDS_WAIT();
#pragma unroll
                for (int d_ = 0; d_ < 4; ++d_)
#pragma unroll
                    for (int r = 0; r < 16; ++r) o[d_][r] *= al_l[crow(r, hi)]; }
            pack_p(p0, p1, pa0, pa1, pa2, pa3);
            if (late) { pend = true; pend_vb = it % 3; } else pv_tile(o, vbase + (it % 3) * SHM, pa0, pa1, pa2, pa3);
        }
        if (it + 1 < ntiles) { VM_WAIT(); stage_write_at(st, lds, MK + (buf ^ 1) * SHM, MV + ((it + 1) % 3) * SHM, kws, vst0, vst1); }
        jcur = jn; sub = subn;
        __syncthreads();
    }
    if (pend) pv_tile(o, vbase + pend_vb * SHM, pa0, pa1, pa2, pa3);
    if (hi == 0) li_l[r32] = l_reg; LDS_WAIT();
    float rli[16];
#pragma unroll
    for (int r = 0; r < 16; ++r) rli[r] = rcpf_(li_l[crow(r, hi)]);
    store_o(o, rli, O + (rowbase + qlo) * D + h * HD, r32, hi);
    __syncthreads();
}
#undef KSWZ
#undef SBAR
}
#ifndef WGM_UP
#define WGM_UP 4
#endif
#ifndef WGM_DN
#define WGM_DN 4
#endif
#ifndef WGM_X
#define WGM_X 4
#endif
#ifndef REP_GEMM
#define REP_GEMM 1
#endif
#ifndef REP_THIN
#define REP_THIN 1
#endif
#ifndef REP_PRO
#define REP_PRO 1
#endif
#ifndef REP_RES
#define REP_RES 1
#endif
#ifndef REP_BAR
#define REP_BAR 1
#endif
#ifndef REP_ATT
#define REP_ATT 1
#endif
struct Args { const float* in[23]; float* out; unsigned char* ws; int ph_lo, ph_hi; };
constexpr int NPHASES = 37;

__global__ void __launch_bounds__(NTHREADS, 2) trunk_fwd(Args args) {
    extern __shared__ __attribute__((aligned(16))) unsigned char lds_raw[];
    LAS unsigned char* lds = (LAS unsigned char*)lds_raw;
    const int G = gridDim.x, bx = blockIdx.x;
    unsigned char* ws = args.ws;
    for (int u = tid_(); u < (LDS_BYTES - LDSCTL_OFF) / 4; u += NTHREADS) ((LAS unsigned*)(lds + LDSCTL_OFF))[u] = 0u;
    __syncthreads();
    const int lo = args.ph_lo, hi = args.ph_hi;
    XcdBarrier bar; bar.bar = (unsigned*)(ws + WS_CTL) + CW_BAR; bar.x = 0; bar.st = nullptr;
    if (hi - lo > 1) bar = xcd_barrier_post((unsigned*)(ws + WS_CTL) + CW_BAR, (volatile LAS unsigned*)(lds + LDSCTL_OFF + 64));
#define INR(k) (lo <= (k) && (k) < hi)
#define IN(k) INR((k) + ((k) >= 1 ? 1 : 0))
#define SEAMR(k) do { if (INR(k) && INR((k) + 1)) xcd_barrier(bar); } while (0)
#define SEAM(k) do { if (IN(k) && IN((k) + 1)) for (int rb_ = 0; rb_ < REP_BAR; ++rb_) xcd_barrier(bar); } while (0)

    const float* x_in = args.in[0]; bf16* xo = (bf16*)(ws + WS_X16);
    bf16* HB = (bf16*)(ws + WS_HB); bf16* MX = (bf16*)(ws + WS_MX); unsigned char* scr = ws + WS_SCR;
    bf16* U = (bf16*)(scr + SCR_U);

    if (IN(0)) for (int rep_ = 0; rep_ < REP_PRO; ++rep_) {
        const int tid = tid_(), lane = tid & 63, wave = __builtin_amdgcn_readfirstlane(tid >> 6), gw = bx * NWAVES + wave, ngw = G * NWAVES;
        LAS float* tscr = (LAS float*)(lds + wave * 16384); int cmoff = 0;
        const int gwp = wave * G + bx;
        for (int j = 0; j < 2; ++j) {
            colmax_matrix(args.in[5] + (size_t)j * D * 2 * RW, D, 2 * RW, (unsigned*)(ws + WS_CTL) + CW_COLMAX_LIN + j * 2 * RW, gwp, ngw, lane, cmoff);
            transpose_matrix(args.in[14] + (size_t)j * RW * D, RW, D, (bf16*)(ws + WS_WLOUT) + (size_t)j * D * RW, tscr, deal_make((unsigned*)(ws + WS_CTL), 2 + j, bx, G, wave), lane);
            gate_weights(args.in[9] + (size_t)j * NBLK * BW * BW, args.in[11] + (size_t)j * NBLK * BW * BW, (bf16*)(ws + WS_WGATE) + (size_t)j * NGATE * BWP);
        }
        colmax_matrix(args.in[16], D, 3 * D, (unsigned*)(ws + WS_CTL) + CW_COLMAX_SQKV, gwp, ngw, lane, cmoff);
        colmax_matrix(args.in[17], D, D, (unsigned*)(ws + WS_CTL) + CW_COLMAX_WO, gwp, ngw, lane, cmoff);
        colmax_matrix(args.in[18], D, 3 * D, (unsigned*)(ws + WS_CTL) + CW_COLMAX_MKV, gwp, ngw, lane, cmoff);
        colmax_matrix(args.in[19], D, D, (unsigned*)(ws + WS_CTL) + CW_COLMAX_WO + D, gwp, ngw, lane, cmoff);
        for (int l = 0; l < DEPTH; ++l) {
            colmax_matrix(args.in[21] + (size_t)l * D * FF, D, FF, (unsigned*)(ws + WS_CTL) + CW_COLMAX + l * FF, gwp, ngw, lane, cmoff);
            colmax_matrix(args.in[22] + (size_t)l * FF * D, FF, D, (unsigned*)(ws + WS_CTL) + CW_COLMAX_DN + l * D, gwp, ngw, lane, cmoff);
        }
        for (int i = bx * NTHREADS + tid; i < 2 * RW; i += G * NTHREADS) { const float lam = args.in[13][i]; ((float*)(ws + WS_SP8))[i] = 8.f * log1pf(expf(-lam)); }
        { const Deal d = deal_make((unsigned*)(ws + WS_CTL), 4, bx, G, wave);
          int m = d.wi * d.ngrp + d.g;
          while (m < M) { const unsigned tk = deal_issue(d, lane);
              norm_row_q(x_in + (size_t)m * D, args.in[1], (signed char*)HB + (size_t)m * D, (float*)(ws + WS_HSCALE) + m, lane);
              m = ((int)__builtin_amdgcn_readfirstlane(tk) + d.nw) * d.ngrp + d.g; } }
    }
    SEAMR(0);
    if (INR(1)) {
        const int tid = tid_(), lane = tid & 63, wave = __builtin_amdgcn_readfirstlane(tid >> 6), gw = bx * NWAVES + wave, ngw = G * NWAVES;
        LAS float* tscr = (LAS float*)(lds + wave * 16384); unsigned* ctl_ = (unsigned*)(ws + WS_CTL);
#define DEAL(site) deal_make(ctl_, site, bx, G, wave)
        quant_transpose_matrix(args.in[17], D, D, (signed char*)(ws + WS_WSO), (const unsigned*)(ws + WS_CTL) + CW_COLMAX_WO, (float*)(ws + WS_WSCALE_WO), tscr, DEAL(20), lane);
        quant_transpose_matrix(args.in[19], D, D, (signed char*)(ws + WS_WMO), (const unsigned*)(ws + WS_CTL) + CW_COLMAX_WO + D, (float*)(ws + WS_WSCALE_WO) + D, tscr, DEAL(21), lane);
        quant_transpose_matrix(args.in[18], D, 3 * D, (signed char*)(ws + WS_WMQKV), (const unsigned*)(ws + WS_CTL) + CW_COLMAX_MKV, (float*)(ws + WS_WSCALE_MKV), tscr, DEAL(22), lane);
        quant_transpose_matrix(args.in[16], D, 3 * D, (signed char*)(ws + WS_WSQKV), (const unsigned*)(ws + WS_CTL) + CW_COLMAX_SQKV, (float*)(ws + WS_WSCALE_SQKV), tscr, DEAL(23), lane);
        for (int j = 0; j < 2; ++j) quant_transpose_matrix(args.in[5] + (size_t)j * D * 2 * RW, D, 2 * RW, (signed char*)(ws + WS_WLIN) + (size_t)j * 2 * RW * D * 2, (const unsigned*)(ws + WS_CTL) + CW_COLMAX_LIN + j * 2 * RW, (float*)(ws + WS_WSCALE_LIN) + j * 2 * RW, tscr, DEAL(24 + j), lane);
        for (int l = 0; l < DEPTH; ++l) quant_transpose_matrix(args.in[22] + (size_t)l * FF * D, FF, D, (signed char*)(ws + WS_WDN) + (size_t)l * D * FF, (const unsigned*)(ws + WS_CTL) + CW_COLMAX_DN + l * D, (float*)(ws + WS_WSCALE_DN) + l * D, tscr, DEAL(26 + l), lane, (int*)(ws + WS_CTL) + CW_CS_DN + l * D);
        for (int l = 0; l < DEPTH; ++l) quant_transpose_matrix(args.in[21] + (size_t)l * D * FF, D, FF, (signed char*)(ws + WS_WUP) + (size_t)l * FF * D, (const unsigned*)(ws + WS_CTL) + CW_COLMAX + l * FF, (float*)(ws + WS_WSCALE) + l * FF, tscr, DEAL(30 + l), lane);
    }
    SEAMR(1);

#define RES_PHASE(XIN_, MX_, GP_, XO_, GN_, HB_) phase_res<1, false, false>(lds, XIN_, MX_, GP_, XO_, GN_, HB_, nullptr, nullptr)
#define RES_PHASE_Q(XIN_, MX_, GP_, XO_, GN_) phase_res<2, false, false>(lds, XIN_, MX_, GP_, XO_, GN_, nullptr, (signed char*)HB, (float*)(ws + WS_HSCALE))
#define GEMM_PHASE(EPI_T, Aptr, Btptr, N_, K_, lda_, ldb_, E_, grp_, akstep_) do { \
        pg8::Gemm g_{(const bf16*)(Aptr), (const bf16*)(Btptr), M, (N_), (K_), (lda_), (ldb_)}; pg8::StaticOrder S_; S_.init(M, (N_), G, bx, (grp_), (akstep_), WGM_X); \
        for (int rep_ = 0; rep_ < REP_GEMM; ++rep_) pg8::gemm_phase<EPI_T, pg8::StaticOrder, true>(lds, g_, S_, E_); } while (0)

#define GEMM_PHASE_I8W(EPI_T, Aptr, Btptr, N_, K2_, E_, W_) do { \
        pg8::Gemm g_{(const bf16*)(Aptr), (const bf16*)(Btptr), M, (N_), (K2_), (K2_), (K2_)}; pg8::StaticOrder S_; S_.init(M, (N_), G, bx, 0, 0, (W_)); \
        for (int rep_ = 0; rep_ < REP_GEMM; ++rep_) pg8::gemm_phase<EPI_T, pg8::StaticOrder, true, true>(lds, g_, S_, E_); } while (0)
#define GEMM_PHASE_I8(EPI_T, Aptr, Btptr, N_, K2_, E_) GEMM_PHASE_I8W(EPI_T, Aptr, Btptr, N_, K2_, E_, WGM_X)
#define UP_PHASE(L) do { pg8::EpiBf16<1> E_{U, FF, nullptr, 0, 0, (const float*)(ws + WS_HSCALE), (const float*)(ws + WS_WSCALE) + (size_t)(L) * FF, nullptr, (unsigned*)(ws + WS_CTL) + CW_ROWMAX + (size_t)(L) * M}; \
        GEMM_PHASE_I8W(pg8::EpiBf16<1>, HB, (signed char*)(ws + WS_WUP) + (size_t)(L) * FF * D, FF, D / 2, E_, WGM_UP); } while (0)
#define DOWN_PHASE(L) do { phase_quant_hidden(lds, DYN_CNT(ws, 0 + (L)), U, (const unsigned*)(ws + WS_CTL) + CW_ROWMAX + (size_t)(L) * M, (signed char*)(scr + SCR_UQ), (float*)(ws + WS_ASCALE)); xcd_barrier(bar); \
        pg8::EpiBf16<0> E_{MX, D, nullptr, 0, 0, (const float*)(ws + WS_ASCALE), (const float*)(ws + WS_WSCALE_DN) + (size_t)(L) * D, (const int*)(ws + WS_CTL) + CW_CS_DN + (size_t)(L) * D, nullptr}; \
        GEMM_PHASE_I8W(pg8::EpiBf16<0>, scr + SCR_UQ, (signed char*)(ws + WS_WDN) + (size_t)(L) * D * FF, D, FF / 2, E_, WGM_DN); } while (0)
#define MLP_PHASES(P, L, XIN, GNEXT, HOUT, QM) do { \
    if (IN(P)) UP_PHASE(L); \
    SEAM(P); \
    if (IN((P) + 1)) DOWN_PHASE(L); \
    SEAM((P) + 1); \
    if (IN((P) + 2)) { if ((QM) == 1) RES_PHASE_Q(XIN, MX, args.in[4] + (size_t)(L) * D, xo, GNEXT); else if ((QM) == 2) phase_res<3, false, false>(lds, XIN, MX, args.in[4] + (size_t)(L) * D, xo, GNEXT, HOUT, (signed char*)(ws + WS_HQ2), (float*)(ws + WS_HSCALE)); else RES_PHASE(XIN, MX, args.in[4] + (size_t)(L) * D, xo, GNEXT, HOUT); } \
    SEAM((P) + 2); } while (0)

#define LRU_PHASES(P, L, J, XIN, XF32) do { \
    bf16* Gb = (bf16*)(scr + SCR_G); bf16* XP = (bf16*)(scr + SCR_XP); bf16* XBp = (bf16*)(scr + SCR_XB); bf16* LAp = (bf16*)(scr + SCR_LA); bf16* INPp = (bf16*)(scr + SCR_INP); bf16* Yp = (bf16*)(scr + SCR_Y); \
    float* SUML = (float*)(scr + SCR_SUML); float* HEND = (float*)(scr + SCR_HEND); \
    if (IN(P)) { pg8::EpiBf16<2> E_{Gb, RW, args.in[6] + (size_t)(J) * 2 * RW, RW, (size_t)(SCR_XP - SCR_G) / 2, (const float*)(ws + WS_HSCALE), (const float*)(ws + WS_WSCALE_LIN) + (size_t)(J) * 2 * RW, nullptr, nullptr}; \
            GEMM_PHASE_I8(pg8::EpiBf16<2>, HB, (signed char*)(ws + WS_WLIN) + (size_t)(J) * 2 * RW * D * 2, 2 * RW, D / 2, E_); } \
    SEAM(P); \
    if (IN((P) + 1)) for (int rep_ = 0; rep_ < REP_THIN; ++rep_) phase_conv(XP, args.in[7] + (size_t)(J) * 4 * RW, args.in[8] + (size_t)(J) * RW, XBp); \
    SEAM((P) + 1); \
    if (IN((P) + 2)) { pg8::EpiGate E_{XBp, LAp, INPp, args.in[10] + (size_t)(J) * RW, args.in[12] + (size_t)(J) * RW, (const float*)(ws + WS_SP8) + (size_t)(J) * RW}; \
        GEMM_PHASE(pg8::EpiGate, XBp, (bf16*)(ws + WS_WGATE) + (size_t)(J) * NGATE * BWP, NGATE, BWP, RWP, BWP, E_, 3, BWP); } \
    SEAM((P) + 2); \
    if (IN((P) + 3)) for (int rep_ = 0; rep_ < REP_THIN; ++rep_) phase_scan1(LAp, INPp, SUML, HEND); \
    SEAM((P) + 3); \
    if (IN((P) + 4)) for (int rep_ = 0; rep_ < REP_THIN; ++rep_) phase_scan2(LAp, INPp, SUML, HEND, Gb, Yp); \
    SEAM((P) + 4); \
    if (IN((P) + 5)) { pg8::EpiBf16<0> E_{MX, D, args.in[15] + (size_t)(J) * D, 0, 0, nullptr, nullptr, nullptr, nullptr}; GEMM_PHASE(pg8::EpiBf16<0>, Yp, (bf16*)(ws + WS_WLOUT) + (size_t)(J) * D * RW, D, RW, RW, RW, E_, 0, 0); } \
    SEAM((P) + 5); \
    if (IN((P) + 6)) phase_res<2, XF32, false>(lds, XIN, MX, args.in[2] + (size_t)(L) * D, xo, args.in[3] + (size_t)(L) * D, nullptr, (signed char*)HB, (float*)(ws + WS_HSCALE)); \
    SEAM((P) + 6); } while (0)

    bf16* Qb = (bf16*)(scr + SCR_Q); bf16* Kb = (bf16*)(scr + SCR_K); bf16* Vb = (bf16*)(scr + SCR_V); bf16* Ob = (bf16*)(scr + SCR_O);

    LRU_PHASES(1, 0, 0, x_in, true);
    MLP_PHASES(8, 0, xo, args.in[1] + (size_t)1 * D, HB, 1);

    if (IN(11)) { pg8::EpiBf16<0> E_{Qb, D, nullptr, D, (size_t)(SCR_K - SCR_Q) / 2, (const float*)(ws + WS_HSCALE), (const float*)(ws + WS_WSCALE_SQKV), nullptr, nullptr}; GEMM_PHASE_I8(pg8::EpiBf16<0>, HB, (signed char*)(ws + WS_WSQKV), 3 * D, D / 2, E_); }
    SEAM(11);
    if (IN(12)) for (int rep_ = 0; rep_ < REP_ATT; ++rep_) {
        if (tid_() == 0) { ((volatile LAS unsigned*)(lds + att::OFF_FLAG))[0] = 0u; ((volatile LAS unsigned*)(lds + att::OFF_FLAG))[1] = 0u; }
        __syncthreads();
        unsigned token = 0u;
        for (int u = bx; u < BATCH * NH * 16; u += G) { const int lu = u >> 3, k = lu >> 4, qb = 15 - (lu & 15), bh = 8 * k + (u & 7);
            att::sb_unit((LAS char*)lds, Qb, Kb, Vb, Ob, bh / NH, bh % NH, qb, token); }
    }
    SEAM(12);
    if (IN(13)) { phase_quant_rows<16>(Ob, (signed char*)(scr + SCR_OQ), (float*)(ws + WS_ASCALE)); xcd_barrier(bar);
        pg8::EpiBf16<0> E_{MX, D, nullptr, 0, 0, (const float*)(ws + WS_ASCALE), (const float*)(ws + WS_WSCALE_WO), nullptr, nullptr}; GEMM_PHASE_I8(pg8::EpiBf16<0>, scr + SCR_OQ, (signed char*)(ws + WS_WSO), D, D / 2, E_); }
    SEAM(13);
    if (IN(14)) RES_PHASE_Q(xo, MX, args.in[2] + (size_t)1 * D, xo, args.in[3] + (size_t)1 * D);
    SEAM(14);
    MLP_PHASES(15, 1, xo, args.in[1] + (size_t)2 * D, HB, 1);

    if (IN(18)) { pg8::EpiBf16<0> E_{Qb, D, nullptr, D, (size_t)(SCR_K - SCR_Q) / 2, (const float*)(ws + WS_HSCALE), (const float*)(ws + WS_WSCALE_MKV), nullptr, nullptr}; GEMM_PHASE_I8(pg8::EpiBf16<0>, HB, (signed char*)(ws + WS_WMQKV), 3 * D, D / 2, E_); }
    SEAM(18);
    if (IN(19)) for (int rep_ = 0; rep_ < REP_THIN; ++rep_) phase_kmean(Kb, (bf16*)(scr + SCR_KMH), (bf16*)(scr + SCR_KML));
    SEAM(19);
    if (IN(20)) for (int rep_ = 0; rep_ < REP_ATT; ++rep_) {
        const bf16* KMH = (const bf16*)(scr + SCR_KMH); const bf16* KML = (const bf16*)(scr + SCR_KML);
        for (int u2 = bx * 2; u2 < BATCH * NH * 16; u2 += G * 2) {
#pragma nounroll
            for (int pass = 0; pass < 2; ++pass) { const int u = u2 >> 1, lu = u >> 3, k = lu >> 3, p = lu & 7, bh = 8 * k + (u & 7);
                att::moba_unit((LAS char*)lds, Qb, Kb, Vb, Ob, KMH, KML, args.in[20], bh / NH, bh % NH, pass ? p : 15 - p); } }
    }
    SEAM(20);
    if (IN(21)) { phase_quant_rows<16>(Ob, (signed char*)(scr + SCR_OQ), (float*)(ws + WS_ASCALE)); xcd_barrier(bar);
        pg8::EpiBf16<0> E_{MX, D, nullptr, 0, 0, (const float*)(ws + WS_ASCALE), (const float*)(ws + WS_WSCALE_WO) + D, nullptr, nullptr}; GEMM_PHASE_I8(pg8::EpiBf16<0>, scr + SCR_OQ, (signed char*)(ws + WS_WMO), D, D / 2, E_); }
    SEAM(21);
    if (IN(22)) RES_PHASE_Q(xo, MX, args.in[2] + (size_t)2 * D, xo, args.in[3] + (size_t)2 * D);
    SEAM(22);
    MLP_PHASES(23, 2, xo, args.in[1] + (size_t)3 * D, HB, 1);

    LRU_PHASES(26, 3, 1, xo, false);
    if (IN(33)) UP_PHASE(3);
    SEAM(33);
    if (IN(34)) DOWN_PHASE(3);
    SEAM(34);
    if (IN(35)) phase_res<0, false, true>(lds, xo, MX, args.in[4] + (size_t)3 * D, args.out, nullptr, nullptr, nullptr, nullptr);
#undef IN
#undef SEAM
}
#ifndef N_LAUNCH_MODE
#define N_LAUNCH_MODE 1
#endif
extern "C" void kernel_launch(void* const* d_in, const int* in_sizes, int n_in, void* d_out, int out_size, void* d_ws, size_t ws_size, hipStream_t stream) {
    static int grid = 0;
    if (grid == 0) {
        if (n_in != 23 || in_sizes[0] != M * D || out_size != M * D || ws_size < WS_END) { fprintf(stderr, "kernel_launch: shape/workspace mismatch (n_in %d, in0 %d, out %d, ws %zu, need %zu)\n", n_in, n_in > 0 ? in_sizes[0] : -1, out_size, ws_size, (size_t)WS_END); grid = -1; return; }
        int dev = 0, cus = 0, per_cu = 0;
        if (hipGetDevice(&dev) != hipSuccess || hipDeviceGetAttribute(&cus, hipDeviceAttributeMultiprocessorCount, dev) != hipSuccess) { grid = -1; return; }
        if (hipFuncSetAttribute((const void*)trunk_fwd, hipFuncAttributeMaxDynamicSharedMemorySize, LDS_BYTES) != hipSuccess) { fprintf(stderr, "kernel_launch: hipFuncSetAttribute failed\n"); grid = -1; return; }
        if (hipOccupancyMaxActiveBlocksPerMultiprocessor(&per_cu, (const void*)trunk_fwd, NTHREADS, LDS_BYTES) != hipSuccess || per_cu < 1) fprintf(stderr, "kernel_launch: occupancy query says %d\n", per_cu);
        (void)hipGetLastError();
        grid = cus;
    }
    if (grid < 0) return;
    (void)hipMemsetAsync((char*)d_ws + WS_CTL, 0, CTL_ZERO_BYTES, stream);
    Args a{};
    for (int i = 0; i < 23; ++i) a.in[i] = (const float*)d_in[i];
    a.out = (float*)d_out; a.ws = (unsigned char*)d_ws;
#if N_LAUNCH_MODE == 1
    a.ph_lo = 0; a.ph_hi = NPHASES;
    hipLaunchKernelGGL(trunk_fwd, dim3(grid), dim3(NTHREADS), LDS_BYTES, stream, a);
#else
    for (int p = 0; p < NPHASES; ++p) { a.ph_lo = p; a.ph_hi = p + 1; hipLaunchKernelGGL(trunk_fwd, dim3(grid), dim3(NTHREADS), LDS_BYTES, stream, a);
#ifdef DEBUG_CHECKS
        debug_checks_after(p, a, stream);
#endif
    }
#ifdef DEBUG_CHECKS
    debug_finish(a, stream);
#endif
#endif
}
```
